# Optimizing an MI355X kernel written in HIP

```python
import math
import jax, jax.numpy as jnp
from jax import lax
import numpy as np

D_MODEL = 1024
BATCH = 4
SEQ = 4096
DEPTH = 4

N_MIXERS = 3
N_HEADS = 8
HEAD_DIM = D_MODEL // N_HEADS
ROT_DIM = HEAD_DIM // 4
ROPE_THETA = 500000.0
MOBA_BLOCK = 256
MOBA_TOPK = 3
Q_CHUNK = 16
POOL_WINDOWS = (2, 4, 8, 16)
N_POOL_GROUPS = len(POOL_WINDOWS)
POOL_GROUP_DIM = D_MODEL // N_POOL_GROUPS
CONV_WIDTH = 3
D_FF = 4 * D_MODEL
NORM_EPS = 1e-6
NEG_INF = -1e30

kernel_name = "hybrid_moba_pool_shortconv_trunk"


def rms_norm(x, g):
    xf = x.astype(jnp.float32)
    y = xf * lax.rsqrt(jnp.mean(xf * xf, axis=-1, keepdims=True) + NORM_EPS)
    return (y * g.astype(jnp.float32)).astype(x.dtype)


def rope_tables(positions):
    inv_freq = ROPE_THETA ** (-jnp.arange(0, ROT_DIM, 2, dtype=jnp.float32) / ROT_DIM)
    ang = positions.astype(jnp.float32)[..., None] * inv_freq
    return jnp.cos(ang)[:, None], jnp.sin(ang)[:, None]


def apply_partial_rope(t, cos, sin):
    half = ROT_DIM // 2
    rot = t[..., :ROT_DIM].astype(jnp.float32)
    x1, x2 = rot[..., :half], rot[..., half:]
    rotated = jnp.concatenate([x1 * cos - x2 * sin, x2 * cos + x1 * sin], axis=-1)
    return jnp.concatenate([rotated.astype(t.dtype), t[..., ROT_DIM:]], axis=-1)


def moba_attention(xn, w_qkv, w_o, cos, sin):
    b, s, _ = xn.shape
    qkv = (xn @ w_qkv).reshape(b, s, 3, N_HEADS, HEAD_DIM)
    q, k, v = [jnp.transpose(qkv[:, :, i], (0, 2, 1, 3)) for i in range(3)]
    q = apply_partial_rope(q, cos, sin)
    k = apply_partial_rope(k, cos, sin)

    n_blocks = -(-s // MOBA_BLOCK)
    top_k = min(MOBA_TOPK, n_blocks)
    pad = n_blocks * MOBA_BLOCK - s
    kp = jnp.pad(k, ((0, 0), (0, 0), (0, pad), (0, 0)))
    vp = jnp.pad(v, ((0, 0), (0, 0), (0, pad), (0, 0)))
    kb = kp.reshape(b, N_HEADS, n_blocks, MOBA_BLOCK, HEAD_DIM)
    vb = vp.reshape(b, N_HEADS, n_blocks, MOBA_BLOCK, HEAD_DIM)
    k_mean = jnp.mean(kb.astype(jnp.float32), axis=3)

    scale = 1.0 / math.sqrt(HEAD_DIM)
    bi = jnp.arange(b)[:, None, None, None]
    hi = jnp.arange(N_HEADS)[None, :, None, None]
    blk_ids = jnp.arange(n_blocks)

    def chunk(c):
        start = c * Q_CHUNK
        qc = lax.dynamic_slice_in_dim(q, start, Q_CHUNK, axis=2)
        qpos = start + jnp.arange(Q_CHUNK)
        qblk = start // MOBA_BLOCK
        gate = jnp.einsum('bhqd,bhnd->bhqn', qc.astype(jnp.float32), k_mean)
        gate = jnp.where(blk_ids < qblk, gate, NEG_INF)
        _, sel = lax.top_k(gate, top_k)
        sel_valid = sel < qblk
        k_sel = kb[bi, hi, sel]
        v_sel = vb[bi, hi, sel]
        s_sel = jnp.einsum('bhqd,bhqnkd->bhqnk', qc, k_sel).astype(jnp.float32) * scale
        s_sel = jnp.where(sel_valid[..., None], s_sel, NEG_INF)
        s_sel = s_sel.reshape(b, N_HEADS, Q_CHUNK, top_k * MOBA_BLOCK)
        k_own = lax.dynamic_slice_in_dim(kp, qblk * MOBA_BLOCK, MOBA_BLOCK, axis=2)
        v_own = lax.dynamic_slice_in_dim(vp, qblk * MOBA_BLOCK, MOBA_BLOCK, axis=2)
        s_own = jnp.einsum('bhqd,bhkd->bhqk', qc, k_own).astype(jnp.float32) * scale
        kpos = qblk * MOBA_BLOCK + jnp.arange(MOBA_BLOCK)
        s_own = jnp.where(kpos[None, :] <= qpos[:, None], s_own, NEG_INF)
        p = jax.nn.softmax(jnp.concatenate([s_sel, s_own], axis=-1), axis=-1)
        p_sel = p[..., :top_k * MOBA_BLOCK].reshape(
            b, N_HEADS, Q_CHUNK, top_k, MOBA_BLOCK).astype(v.dtype)
        p_own = p[..., top_k * MOBA_BLOCK:].astype(v.dtype)
        return (jnp.einsum('bhqnk,bhqnkd->bhqd', p_sel, v_sel)
                + jnp.einsum('bhqk,bhkd->bhqd', p_own, v_own))

    outs = lax.map(chunk, jnp.arange(s // Q_CHUNK))
    out = jnp.transpose(outs, (1, 0, 3, 2, 4)).reshape(b, s, D_MODEL)
    return out @ w_o


def pool_mixer(xn, w_groups, ls_scale):
    b, s, _ = xn.shape
    xf = xn.astype(jnp.float32).reshape(b, s, N_POOL_GROUPS, POOL_GROUP_DIM)
    cs = jnp.concatenate([jnp.zeros((b, 1, N_POOL_GROUPS, POOL_GROUP_DIM), jnp.float32),
                          jnp.cumsum(xf, axis=1)], axis=1)
    t = jnp.arange(s)
    pooled = []
    for g, w in enumerate(POOL_WINDOWS):
        c = cs[:, :, g]
        lower = jnp.pad(c[:, :s - w + 1], ((0, 0), (w - 1, 0), (0, 0)))
        count = jnp.minimum(t + 1, w).astype(jnp.float32)[None, :, None]
        pooled.append((c[:, 1:] - lower) / count)
    pooled = jnp.stack(pooled, axis=2) - xf
    y = jnp.einsum('bsgc,gcd->bsgd', pooled.astype(xn.dtype), w_groups)
    return y.reshape(b, s, D_MODEL) * ls_scale


def short_conv_mixer(xn, w_in, conv_w, w_out):
    u = xn @ w_in
    gate_b, gate_c, h = jnp.split(u, 3, axis=-1)
    z = gate_c * h
    zc = lax.conv_general_dilated(
        z, conv_w[:, None, :].astype(z.dtype), window_strides=(1,),
        padding=[(CONV_WIDTH - 1, 0)], dimension_numbers=('NWC', 'WIO', 'NWC'),
        feature_group_count=D_MODEL)
    return (gate_b * zc) @ w_out


def squared_relu_mlp(x, w_up, w_down):
    h = jax.nn.relu(x @ w_up)
    return (h * h) @ w_down


def setup_inputs(seed: int = 0) -> dict:
    key = jax.random.key(seed)
    ks = jax.random.split(key, 16)
    n_attn = len(range(0, DEPTH, N_MIXERS))
    n_pool = len(range(1, DEPTH, N_MIXERS))
    n_conv = len(range(2, DEPTH, N_MIXERS))
    f32 = jnp.float32

    def nrm(k, shape, fan_in):
        return jax.random.normal(k, shape, f32) * (fan_in ** -0.5)

    x = jax.random.normal(ks[0], (BATCH, SEQ, D_MODEL), f32)
    positions = jnp.broadcast_to(jnp.arange(SEQ, dtype=jnp.int32), (BATCH, SEQ))
    norm_mix = 1.0 + 0.02 * jax.random.normal(ks[1], (DEPTH, D_MODEL), f32)
    norm_mlp = 1.0 + 0.02 * jax.random.normal(ks[2], (DEPTH, D_MODEL), f32)
    attn_w_qkv = nrm(ks[3], (n_attn, D_MODEL, 3 * D_MODEL), D_MODEL)
    attn_w_o = nrm(ks[4], (n_attn, D_MODEL, D_MODEL), D_MODEL)
    pool_w = nrm(ks[5], (n_pool, N_POOL_GROUPS, POOL_GROUP_DIM, POOL_GROUP_DIM), POOL_GROUP_DIM)
    pool_scale = 1.0 + 0.1 * jax.random.normal(ks[6], (n_pool, D_MODEL), f32)
    conv_w_in = nrm(ks[7], (n_conv, D_MODEL, 3 * D_MODEL), D_MODEL)
    conv_w = nrm(ks[8], (n_conv, CONV_WIDTH, D_MODEL), CONV_WIDTH)
    conv_w_out = nrm(ks[9], (n_conv, D_MODEL, D_MODEL), D_MODEL)
    mlp_w_up = nrm(ks[10], (DEPTH, D_MODEL, D_FF), D_MODEL)
    mlp_w_down = nrm(ks[11], (DEPTH, D_FF, D_MODEL), D_FF)
    norm_final = 1.0 + 0.02 * jax.random.normal(ks[12], (D_MODEL,), f32)
    return {"x": x, "positions": positions, "norm_mix": norm_mix, "norm_mlp": norm_mlp,
            "attn_w_qkv": attn_w_qkv, "attn_w_o": attn_w_o,
            "pool_w": pool_w, "pool_scale": pool_scale,
            "conv_w_in": conv_w_in, "conv_w": conv_w, "conv_w_out": conv_w_out,
            "mlp_w_up": mlp_w_up, "mlp_w_down": mlp_w_down, "norm_final": norm_final}


def reference(x, positions, norm_mix, norm_mlp, attn_w_qkv, attn_w_o, pool_w, pool_scale,
              conv_w_in, conv_w, conv_w_out, mlp_w_up, mlp_w_down, norm_final):
    cos, sin = rope_tables(positions)
    i_attn = i_pool = i_conv = 0
    for i in range(DEPTH):
        xn = rms_norm(x, norm_mix[i])
        kind = i % N_MIXERS
        if kind == 0:
            y = moba_attention(xn, attn_w_qkv[i_attn], attn_w_o[i_attn], cos, sin)
            i_attn += 1
        elif kind == 1:
            y = pool_mixer(xn, pool_w[i_pool], pool_scale[i_pool])
            i_pool += 1
        else:
            y = short_conv_mixer(xn, conv_w_in[i_conv], conv_w[i_conv], conv_w_out[i_conv])
            i_conv += 1
        x = x + y
        x = x + squared_relu_mlp(rms_norm(x, norm_mlp[i]), mlp_w_up[i], mlp_w_down[i])
    return rms_norm(x, norm_final)
```

```cpp
#include <hip/hip_runtime.h>
#include <hip/hip_bf16.h>
#include <hip/hip_cooperative_groups.h>
#include <cstdio>
#include <cstdint>
namespace cg = cooperative_groups;

#ifndef PM
#define PM 0xff
#endif
#ifndef PROBE_REPEAT
#define PROBE_REPEAT -1
#endif
#ifndef MK_ONE_LAUNCH
#define MK_ONE_LAUNCH 1
#endif

__device__ __forceinline__ int opaque_tid() { int t = threadIdx.x; asm volatile("" : "+v"(t)); return t; }
namespace pg8 {
#define PG8_LAS __attribute__((address_space(3)))
typedef unsigned short bf16_t;
typedef short bf16x8 __attribute__((ext_vector_type(8)));
typedef float f32x4 __attribute__((ext_vector_type(4)));
typedef unsigned u32x4 __attribute__((ext_vector_type(4)));
typedef unsigned u32x2 __attribute__((ext_vector_type(2)));
constexpr int BM = 256, BK = 64, HALF = 128, HTB = HALF * BK * 2, STAGE_BYTES = 8 * HTB, NXCD = 8, WGM = 8;

__host__ __device__ __forceinline__ int lds_byte(int r, int c) { const int st = (r >> 4) * 2 + (c >> 5), rr = r & 15, cc = c & 31, ob = rr * 64 + cc * 2; return st * 1024 + (ob ^ (((ob >> 9) & 1) << 5)); }
__host__ __device__ __forceinline__ void stage_rc(int b, int& R, int& C) { const int st = b / 1024, sb = b % 1024, swz = sb ^ (((sb >> 9) & 1) << 5); R = (st >> 1) * 16 + swz / 64; C = (st & 1) * 32 + (swz % 64) / 2; }
__host__ __device__ __forceinline__ int perm32(int rho) { const int n = rho >> 4, i = rho & 15; return 8 * (i >> 2) + 4 * n + (i & 3); }

struct Unit { int pm, pn; };
struct Gemm { const bf16_t* A; const bf16_t* Bt; int M, N, K, lda, ldb, a_pn, tiled; };

struct StaticOrder {
    int nM, nN, nwg, G, c;
    __host__ __device__ void init(int M, int N, int G_, int c_) { nM = M / BM; nN = N / BM; nwg = nM * nN; G = G_; c = c_; }
    __host__ __device__ bool next(int i, Unit& u) const {
        const long L = (long)i * G + c; if (L >= nwg) return false;
        int wgid = (int)L; { const int q = nwg / NXCD, r = nwg % NXCD, xcd = wgid % NXCD, off = wgid / NXCD; wgid = (xcd < r ? xcd * (q + 1) : r * (q + 1) + (xcd - r) * q) + off; }
        const int nig = WGM * nN, gid = wgid / nig, fm = gid * WGM, gsz = (nM - fm) < WGM ? (nM - fm) : WGM;
        u.pm = fm + ((wgid % nig) % gsz); u.pn = (wgid % nig) / gsz; return true;
    }
};

__device__ __forceinline__ unsigned cvt_pk_bf16(float lo, float hi) { unsigned r; asm volatile("v_cvt_pk_bf16_f32 %0, %1, %2" : "=v"(r) : "v"(lo), "v"(hi)); return r; }
__device__ __forceinline__ u32x4 pack8(f32x4 a, f32x4 b) { u32x4 w; w.x = cvt_pk_bf16(a[0], a[1]); w.y = cvt_pk_bf16(a[2], a[3]); w.z = cvt_pk_bf16(b[0], b[1]); w.w = cvt_pk_bf16(b[2], b[3]); return w; }

__device__ __forceinline__ float row_rstd(const float* ss, int row) {
    const f32x4* p = (const f32x4*)(ss + (size_t)row * 16);
    const f32x4 a = p[0], b = p[1], c = p[2], d = p[3];
    const float s = (((a[0] + a[1]) + (a[2] + a[3])) + ((b[0] + b[1]) + (b[2] + b[3]))) + (((c[0] + c[1]) + (c[2] + c[3])) + ((d[0] + d[1]) + (d[2] + d[3])));
    return __builtin_amdgcn_rsqf(s * (1.0f / 1024.0f) + 1e-6f);
}


struct RstdIni { f32x4 a, b; };
__device__ __forceinline__ void rstd_load(const float* ss, RstdIni& ini, int pm) {
    const int tid = opaque_tid();
    const f32x4* q = (const f32x4*)(ss + (size_t)(pm * BM + (tid >> 1)) * 16 + (tid & 1) * 8);
    ini.a = q[0]; ini.b = q[1];
}
__device__ __forceinline__ void rstd_store(PG8_LAS float* tab, const RstdIni& ini, int par) {
    const int tid = opaque_tid();
    float s = ((ini.a[0] + ini.a[1]) + (ini.a[2] + ini.a[3])) + ((ini.b[0] + ini.b[1]) + (ini.b[2] + ini.b[3]));
    s += __shfl_xor(s, 1);
    if (!(tid & 1)) tab[par * BM + (tid >> 1)] = __builtin_amdgcn_rsqf(s * (1.0f / 1024.0f) + 1e-6f);
}
__device__ __forceinline__ void rstd_read(PG8_LAS float* tab, int par, int wr, int fr, float (&rs)[2][4]) {
#pragma unroll
    for (int ai = 0; ai < 2; ++ai)
#pragma unroll
        for (int m = 0; m < 4; ++m) rs[ai][m] = tab[par * BM + ai * HALF + wr * 64 + m * 16 + fr];
}
#define PG8_ZERO_ACC(acc) do { _Pragma("unroll") for (int a_ = 0; a_ < 2; ++a_) _Pragma("unroll") for (int b_ = 0; b_ < 2; ++b_) _Pragma("unroll") for (int m_ = 0; m_ < 4; ++m_) _Pragma("unroll") for (int n_ = 0; n_ < 2; ++n_) \
    acc[a_][b_][m_][n_] = (f32x4){0.f, 0.f, 0.f, 0.f}; } while (0)
#define PG8_RSTD_HOOKS \
    typedef RstdIni Ini; \
    __device__ __forceinline__ void init_load(f32x4 (&acc)[2][2][4][2], Ini& ini, const Unit& u, int, int, int, int) const { PG8_ZERO_ACC(acc); rstd_load(ss, ini, u.pm); } \
    __device__ __forceinline__ void init_apply(f32x4 (&)[2][2][4][2], const Ini& ini, const Unit&, int, int, int, int, int par) const { rstd_store(tab, ini, par); } \
    __device__ __forceinline__ void next_load(Ini& ini, const Unit& nx) const { rstd_load(ss, ini, nx.pm); } \
    __device__ __forceinline__ void next_apply(f32x4 (&acc)[2][2][4][2], Ini& ini, const Unit&, int, int, int, int, int par) const { PG8_ZERO_ACC(acc); rstd_store(tab, ini, par); }

struct EpiUp {
    static constexpr bool PERM = true;
    bf16_t* H; const float* ss; PG8_LAS float* tab;
    PG8_RSTD_HOOKS
    __device__ __forceinline__ void operator()(const f32x4 (&acc)[2][2][4][2], const Unit& u, int wr, int wc, int fr, int fq, int par) const {
        const int row0 = u.pm * BM + wr * 64 + fr, col0 = u.pn * BM + wc * 32 + 8 * fq;
        float rsv[2][4]; rstd_read(tab, par, wr, fr, rsv);
#pragma unroll
        for (int ai = 0; ai < 2; ++ai)
#pragma unroll
            for (int m = 0; m < 4; ++m) { const float rs = rsv[ai][m];
                bf16_t* rowp = H + ((size_t)(u.pm * 64 + u.pn * 4 + (wc >> 1)) * 256 + (ai * HALF + wr * 64 + m * 16 + fr)) * 64 + (wc & 1) * 32 + 8 * fq;
#pragma unroll
                for (int bj = 0; bj < 2; ++bj) { f32x4 v0 = acc[ai][bj][m][0] * rs, v1 = acc[ai][bj][m][1] * rs;
#pragma unroll
                    for (int j = 0; j < 4; ++j) { const float a = fmaxf(v0[j], 0.f), b = fmaxf(v1[j], 0.f); v0[j] = a * a; v1[j] = b * b; }
                    *(u32x4*)(rowp + (size_t)bj * 2 * 16384) = pack8(v0, v1); } }
    }
};

struct EpiRes {
    static constexpr bool PERM = true;
    const float* Xin32; bf16_t* xb; float* ssout; const float* cscale;
    struct Ini { u32x4 x[2][4][2]; };
    __device__ __forceinline__ void init_load(f32x4 (&acc)[2][2][4][2], Ini& ini, const Unit& u, int wr, int wc, int fr, int fq) const {
        const int row0 = u.pm * BM + wr * 64 + fr, col0 = u.pn * BM + wc * 32 + 8 * fq;
#pragma unroll
        for (int ai = 0; ai < 2; ++ai)
#pragma unroll
            for (int m = 0; m < 4; ++m)
#pragma unroll
                for (int bj = 0; bj < 2; ++bj) ini.x[ai][m][bj] = *(const u32x4*)(xb + (size_t)(row0 + ai * HALF + m * 16) * 1024 + col0 + bj * HALF);
    }
    __device__ __forceinline__ void next_load(Ini&, const Unit&) const {}
    __device__ __forceinline__ void next_apply(f32x4 (&acc)[2][2][4][2], Ini& ini, const Unit& u, int wr, int wc, int fr, int fq, int par) const { init_load(acc, ini, u, wr, wc, fr, fq); init_apply(acc, ini, u, wr, wc, fr, fq, par); }
    __device__ __forceinline__ void init_apply(f32x4 (&acc)[2][2][4][2], const Ini& ini, const Unit& u, int wr, int wc, int fr, int fq, int) const {
        const int col0 = u.pn * BM + wc * 32 + 8 * fq;
        f32x4 is[2][2];
#pragma unroll
        for (int bj = 0; bj < 2; ++bj)
#pragma unroll
            for (int n = 0; n < 2; ++n) { is[bj][n] = (f32x4){1.f, 1.f, 1.f, 1.f};
                if (cscale) { const f32x4 sc = *(const f32x4*)(cscale + col0 + bj * HALF + 4 * n);
#pragma unroll
                    for (int j = 0; j < 4; ++j) is[bj][n][j] = __builtin_amdgcn_rcpf(sc[j]); } }
#pragma unroll
        for (int ai = 0; ai < 2; ++ai)
#pragma unroll
            for (int m = 0; m < 4; ++m)
#pragma unroll
                for (int bj = 0; bj < 2; ++bj) { const u32x4 w = ini.x[ai][m][bj];
                    acc[ai][bj][m][0] = (f32x4){__uint_as_float(w.x << 16), __uint_as_float(w.x & 0xffff0000u), __uint_as_float(w.y << 16), __uint_as_float(w.y & 0xffff0000u)} * is[bj][0];
                    acc[ai][bj][m][1] = (f32x4){__uint_as_float(w.z << 16), __uint_as_float(w.z & 0xffff0000u), __uint_as_float(w.w << 16), __uint_as_float(w.w & 0xffff0000u)} * is[bj][1]; }
    }
    __device__ __forceinline__ void operator()(const f32x4 (&acc)[2][2][4][2], const Unit& u, int wr, int wc, int fr, int fq, int par) const {
        const int row0 = u.pm * BM + wr * 64 + fr, col0 = u.pn * BM + wc * 32 + 8 * fq;
        f32x4 sc[2][2];
#pragma unroll
        for (int bj = 0; bj < 2; ++bj)
#pragma unroll
            for (int n = 0; n < 2; ++n) sc[bj][n] = cscale ? *(const f32x4*)(cscale + col0 + bj * HALF + 4 * n) : (f32x4){1.f, 1.f, 1.f, 1.f};
#pragma unroll
        for (int ai = 0; ai < 2; ++ai)
#pragma unroll
            for (int m = 0; m < 4; ++m) { const size_t off = (size_t)(row0 + ai * HALF + m * 16) * 1024 + col0; float qq = 0.f;
#pragma unroll
                for (int bj = 0; bj < 2; ++bj) { const f32x4 o0 = acc[ai][bj][m][0] * sc[bj][0], o1 = acc[ai][bj][m][1] * sc[bj][1];
                    *(u32x4*)(xb + off + bj * HALF) = pack8(o0, o1);
                    qq += ((o0[0] * o0[0] + o0[1] * o0[1]) + (o0[2] * o0[2] + o0[3] * o0[3])) + ((o1[0] * o1[0] + o1[1] * o1[1]) + (o1[2] * o1[2] + o1[3] * o1[3])); }
                qq += __shfl_xor(qq, 16); qq += __shfl_xor(qq, 32);
                if (fq == 0) ssout[(size_t)(row0 + ai * HALF + m * 16) * 16 + u.pn * 4 + wc] = qq; }
    }
};

struct EpiQKV {
    static constexpr bool PERM = true;
    bf16_t* QKV; size_t tstride; const float* ss; const float* rope; float* kmean; PG8_LAS float* tab;
    PG8_RSTD_HOOKS
    __device__ __forceinline__ void operator()(const f32x4 (&acc)[2][2][4][2], const Unit& u, int wr, int wc, int fr, int fq, int par) const {
        const int t = u.pn >> 2;
        bf16_t* base = QKV + (size_t)t * tstride;
        const int b = u.pm >> 4, blk = u.pm & 15;
        const int cih = wc * 32 + 8 * fq;
        const int row0 = u.pm * BM + wr * 64 + fr;
        float rsv[2][4]; rstd_read(tab, par, wr, fr, rsv);
        f32x4 cs[2][2];
#pragma unroll
        for (int bj = 0; bj < 2; ++bj)
#pragma unroll
            for (int n = 0; n < 2; ++n) cs[bj][n] = (f32x4){0.f, 0.f, 0.f, 0.f};
        const bool rot = (t < 2 && wc == 0);
#pragma unroll
        for (int ap = 0; ap < 4; ++ap) {
            const int ai = ap >> 1, mp = ap & 1;
            f32x4 c[2][2], sn[2][2];
            if (rot) {
#pragma unroll
                for (int mm = 0; mm < 2; ++mm) { const float* cp = rope + (size_t)(row0 + ai * HALF + (2 * mp + mm) * 16) * 32 + 8 * (fq & 1);
                    c[mm][0] = *(const f32x4*)(cp); c[mm][1] = *(const f32x4*)(cp + 4); sn[mm][0] = *(const f32x4*)(cp + 16); sn[mm][1] = *(const f32x4*)(cp + 20); }
            }
#pragma unroll
            for (int mm = 0; mm < 2; ++mm) { const int m = 2 * mp + mm;
                const int row = row0 + ai * HALF + m * 16; const int s = row & 4095; const float rs = rsv[ai][m];
                f32x4 v[2][2];
#pragma unroll
                for (int bj = 0; bj < 2; ++bj)
#pragma unroll
                    for (int n = 0; n < 2; ++n) v[bj][n] = acc[ai][bj][m][n] * rs;
                if (rot) {
                    const float sgn = (fq < 2) ? -1.f : 1.f;
#pragma unroll
                    for (int bj = 0; bj < 2; ++bj)
#pragma unroll
                        for (int n = 0; n < 2; ++n)
#pragma unroll
                            for (int j = 0; j < 4; ++j) { const float mine = v[bj][n][j]; const float other = __shfl_xor(mine, 32); v[bj][n][j] = mine * c[mm][n][j] + sgn * other * sn[mm][n][j]; }
                }
#pragma unroll
                for (int bj = 0; bj < 2; ++bj) {
                    const int h = 2 * (u.pn & 3) + bj;
                    bf16_t* dst = base + ((size_t)((b * 8 + h) * 4096 + s)) * 128 + cih;
                    *(u32x4*)dst = pack8(v[bj][0], v[bj][1]);
                    cs[bj][0] += v[bj][0]; cs[bj][1] += v[bj][1];
                }
            }
        }
        if (t == 1) {
#pragma unroll
            for (int bj = 0; bj < 2; ++bj)
#pragma unroll
                for (int n = 0; n < 2; ++n)
#pragma unroll
                    for (int j = 0; j < 4; ++j) { float x = cs[bj][n][j]; x += __shfl_xor(x, 1); x += __shfl_xor(x, 2); x += __shfl_xor(x, 4); x += __shfl_xor(x, 8);
                        if (fr == 0) { const int h = 2 * (u.pn & 3) + bj; atomicAdd(kmean + ((size_t)((b * 8 + h) * 16 + blk)) * 128 + cih + 4 * n + j, x); } }
        }
    }
};

struct EpiConvIn {
    static constexpr bool PERM = true;
    bf16_t* Z; bf16_t* GB; const float* ss; PG8_LAS float* tab;
    PG8_RSTD_HOOKS
    __device__ __forceinline__ void operator()(const f32x4 (&acc)[2][2][4][2], const Unit& u, int wr, int wc, int fr, int fq, int par) const {
        const int row0 = u.pm * BM + wr * 64 + fr;
        float rsv[2][4]; rstd_read(tab, par, wr, fr, rsv);
#pragma unroll
        for (int ai = 0; ai < 2; ++ai)
#pragma unroll
            for (int m = 0; m < 4; ++m) { const int row = row0 + ai * HALF + m * 16; const float rs = rsv[ai][m];
                if (u.pn < 8) { const float rs2 = rs * rs;
                    const f32x4 z0 = acc[ai][0][m][0] * acc[ai][1][m][0] * rs2, z1 = acc[ai][0][m][1] * acc[ai][1][m][1] * rs2;
                    *(u32x4*)(Z + (size_t)row * 1024 + u.pn * 128 + wc * 32 + 8 * fq) = pack8(z0, z1);
                } else {
#pragma unroll
                    for (int bj = 0; bj < 2; ++bj)
                        *(u32x4*)(GB + (size_t)row * 1024 + (u.pn - 8) * 256 + bj * HALF + wc * 32 + 8 * fq) = pack8(acc[ai][bj][m][0] * rs, acc[ai][bj][m][1] * rs);
                } }
    }
};

template <class Epi>
__device__ __forceinline__ void gemm_phase(PG8_LAS unsigned char* lds, const Gemm g, const StaticOrder& S, const Epi& E) {
    const int tid = opaque_tid(), wid = __builtin_amdgcn_readfirstlane(tid >> 6), lane = tid & 63, wr = wid >> 2, wc = wid & 3, fr = lane & 15, fq = lane >> 4;
    const int K = g.K, nt = K / BK;
    const bool tA = (g.tiled & 1) != 0, tB = (g.tiled & 2) != 0;
    unsigned voffA[2], voffB[2];
#pragma unroll
    for (int i = 0; i < 2; ++i) { int R, C; stage_rc(tid * 16 + i * 8192, R, C); const int Rb = Epi::PERM ? ((R & ~31) + perm32(R & 31)) : R;
        voffA[i] = (unsigned)(R * (tA ? BK : g.lda) + C) * 2u; voffB[i] = (unsigned)(Rb * (tB ? BK : g.ldb) + C) * 2u; }
    const size_t kstepA = tA ? (size_t)(BM * BK * 2) : (size_t)(BK * 2), kstepB = tB ? (size_t)(BM * BK * 2) : (size_t)(BK * 2);
    const size_t hstepA = (size_t)HALF * (tA ? BK : g.lda) * 2, hstepB = (size_t)HALF * (tB ? BK : g.ldb) * 2;
    const size_t tstepA = tA ? (size_t)nt * (BM * BK * 2) : 2 * hstepA, tstepB = tB ? (size_t)nt * (BM * BK * 2) : 2 * hstepB;
    const unsigned ldsw = (unsigned)wid * 1024u;
    const int aoff = lds_byte(wr * 64 + fr, fq * 8), boff = lds_byte(wc * 32 + fr, fq * 8);
#define PG8_SA(b, h) (((b) * 2 + (h)) * HTB)
#define PG8_SB(b, h) ((4 + (b) * 2 + (h)) * HTB)
#define PG8_STAGE(bufoff, gbase, voff) do { _Pragma("unroll") for (int _i = 0; _i < 2; ++_i) \
        __builtin_amdgcn_global_load_lds((const unsigned*)((const char*)(gbase) + (voff)[_i]), (PG8_LAS unsigned*)(lds + (bufoff) + ldsw + _i * 8192), 16, 0, 0); } while (0)
#define PG8_LDA(dst, b, h) do { _Pragma("unroll") for (int m = 0; m < 4; ++m) _Pragma("unroll") for (int k = 0; k < 2; ++k) dst[m][k] = *(const PG8_LAS bf16x8*)(lds + PG8_SA(b, h) + aoff + m * 2048 + k * 1024); } while (0)
#define PG8_LDB(dst, b, h) do { _Pragma("unroll") for (int n = 0; n < 2; ++n) _Pragma("unroll") for (int k = 0; k < 2; ++k) dst[n][k] = *(const PG8_LAS bf16x8*)(lds + PG8_SB(b, h) + boff + n * 2048 + k * 1024); } while (0)
#define PG8_MMA(ai, bj, At, Bt) do { __builtin_amdgcn_s_setprio(1); _Pragma("unroll") for (int m = 0; m < 4; ++m) _Pragma("unroll") for (int n = 0; n < 2; ++n) _Pragma("unroll") for (int k = 0; k < 2; ++k) \
        acc[ai][bj][m][n] = __builtin_amdgcn_mfma_f32_16x16x32_bf16(Bt[n][k], At[m][k], acc[ai][bj][m][n], 0, 0, 0); __builtin_amdgcn_s_setprio(0); } while (0)
#define PG8_WAIT_V(n) asm volatile("s_waitcnt vmcnt(" #n ")" ::: "memory")
#define PG8_WAIT_L(n) asm volatile("s_waitcnt lgkmcnt(" #n ")" ::: "memory")
#define PG8_BAR __builtin_amdgcn_s_barrier()
#define PG8_SCHED __builtin_amdgcn_sched_barrier(0)
    Unit cur, nxt; int ui = 0;
    if (!S.next(0, cur)) return;
    f32x4 acc[2][2][4][2];
    typename Epi::Ini ini;
    E.init_load(acc, ini, cur, wr, wc, fr, fq);
    bf16x8 At[4][2], B0[2][2], B1[2][2];
    const char* cA = (const char*)g.A + (size_t)cur.pm * tstepA + (size_t)cur.pn * g.a_pn * 2; const char* cB = (const char*)g.Bt + (size_t)cur.pn * tstepB;
    PG8_STAGE(PG8_SB(0, 0), cB, voffB); PG8_STAGE(PG8_SB(0, 1), cB + hstepB, voffB); PG8_STAGE(PG8_SA(0, 0), cA, voffA); PG8_STAGE(PG8_SA(0, 1), cA + hstepA, voffA);
    if (wr == 1) PG8_BAR;
    PG8_WAIT_V(2); PG8_BAR;
    PG8_STAGE(PG8_SB(1, 0), cB + kstepB, voffB); PG8_STAGE(PG8_SA(1, 0), cA + kstepA, voffA); PG8_STAGE(PG8_SB(1, 1), cB + hstepB + kstepB, voffB);
    PG8_WAIT_V(6); PG8_BAR;
    E.init_apply(acc, ini, cur, wr, wc, fr, fq, 0);
    for (;;) {
        const bool has_next = S.next(ui + 1, nxt);
        const char* nA = has_next ? (const char*)g.A + (size_t)nxt.pm * tstepA + (size_t)nxt.pn * g.a_pn * 2 : cA; const char* nB = has_next ? (const char*)g.Bt + (size_t)nxt.pn * tstepB : cB;
        for (int t = 0; t < nt; t += 2) {
            const bool last = (t == nt - 2);
            const char* a1 = cA + (size_t)(t + 1) * kstepA;
            const char* a2 = last ? nA : cA + (size_t)(t + 2) * kstepA; const char* b2 = last ? nB : cB + (size_t)(t + 2) * kstepB;
            const char* a3 = a2 + kstepA; const char* b3 = b2 + kstepB;
            PG8_LDB(B0, 0, 0); PG8_LDB(B1, 0, 1); PG8_SCHED; PG8_LDA(At, 0, 0); PG8_STAGE(PG8_SA(1, 1), a1 + hstepA, voffA);
            PG8_WAIT_V(8); PG8_WAIT_L(0); PG8_BAR; PG8_MMA(0, 0, At, B0); PG8_MMA(0, 1, At, B1); PG8_BAR; PG8_SCHED;
            PG8_LDA(At, 0, 1); PG8_STAGE(PG8_SB(0, 0), b2, voffB); PG8_STAGE(PG8_SB(0, 1), b2 + hstepB, voffB); PG8_STAGE(PG8_SA(0, 0), a2, voffA);
            PG8_WAIT_V(8); PG8_WAIT_L(0); PG8_BAR; PG8_MMA(1, 0, At, B0); PG8_MMA(1, 1, At, B1); PG8_BAR; PG8_SCHED;
            PG8_LDB(B0, 1, 0); PG8_LDB(B1, 1, 1); PG8_SCHED; PG8_LDA(At, 1, 0); PG8_STAGE(PG8_SA(0, 1), a2 + hstepA, voffA);
            PG8_WAIT_V(8); PG8_WAIT_L(0); PG8_BAR; PG8_MMA(0, 0, At, B0); PG8_MMA(0, 1, At, B1); PG8_BAR; PG8_SCHED;
            PG8_LDA(At, 1, 1); PG8_STAGE(PG8_SB(1, 0), b3, voffB); PG8_STAGE(PG8_SB(1, 1), b3 + hstepB, voffB); PG8_STAGE(PG8_SA(1, 0), a3, voffA);
            PG8_WAIT_V(8); PG8_WAIT_L(0); PG8_BAR; PG8_MMA(1, 0, At, B0); PG8_MMA(1, 1, At, B1); PG8_BAR; PG8_SCHED;
        }
        if (wr == 0) PG8_BAR;
        if (has_next) E.next_load(ini, nxt);
        E(acc, cur, wr, wc, fr, fq, ui & 1);
        if (!has_next) break;
        cur = nxt; cA = nA; cB = nB; ++ui;
        E.next_apply(acc, ini, cur, wr, wc, fr, fq, ui & 1);
        if (wr == 1) PG8_BAR;
    }
    PG8_WAIT_V(0);
    PG8_BAR;
#undef PG8_SA
#undef PG8_SB
#undef PG8_STAGE
#undef PG8_LDA
#undef PG8_LDB
#undef PG8_MMA
#undef PG8_WAIT_V
#undef PG8_WAIT_L
#undef PG8_BAR
#undef PG8_SCHED
}
}

namespace att {
typedef unsigned short bf16;
typedef short bf16x8 __attribute__((ext_vector_type(8)));
typedef short s16x4 __attribute__((ext_vector_type(4)));
typedef float f32x16 __attribute__((ext_vector_type(16)));
typedef float f32x4 __attribute__((ext_vector_type(4)));
typedef unsigned u32x4 __attribute__((ext_vector_type(4)));
constexpr int D = 128, OSTR = 1024;
constexpr float SCALE = 0.08838834764831845f;
constexpr float THR = 8.f;
constexpr int NW = 8, QBLK = 32, KVBLK = 64, QB = NW * QBLK;
constexpr int SHM_V = KVBLK * D * 2, SHM_K = KVBLK * D * 2;
constexpr int LDS_BYTES = 2 * SHM_V + 2 * SHM_K + NW * 64 * 4;

#define KSWZ(row, colB) ((row) * 256 + ((colB) ^ (((row) & 7) << 4)))
#define SBAR() __builtin_amdgcn_sched_barrier(0)
__device__ __forceinline__ int v_st(int k, int c) { const int kk = (k & ~0xC) | ((k & 4) << 1) | ((k & 8) >> 1); return ((kk >> 3) * 4 + (c >> 5)) * 512 + ((kk & 7) * 32 + (c & 31)) * 2; }
__device__ __forceinline__ int v_rd_base(int lane) { return ((lane & 3) << 3) | (((lane >> 2) & 3) << 6) | (((lane >> 4) & 1) << 5) | (((lane >> 5) & 1) << 8); }
constexpr int v_rd_off(int d0, int ks, int half) { return d0 * 512 + ks * 4096 + half * 2048; }
__device__ __forceinline__ int crow(int r, int hi) { return (r & 3) + 8 * (r >> 2) + 4 * hi; }
__device__ __forceinline__ unsigned cvtpk(float lo, float hi) { unsigned r; asm volatile("v_cvt_pk_bf16_f32 %0, %1, %2" : "=v"(r) : "v"(lo), "v"(hi)); return r; }
__device__ __forceinline__ bf16x8 pack8(f32x4 a, f32x4 b) { u32x4 w = {cvtpk(a[0], a[1]), cvtpk(a[2], a[3]), cvtpk(b[0], b[1]), cvtpk(b[2], b[3])}; return *reinterpret_cast<bf16x8*>(&w); }
__device__ __forceinline__ bf16x8 load8(const bf16* p) { return *reinterpret_cast<const bf16x8*>(p); }

__device__ __forceinline__ void mask_tile(f32x16& p0, f32x16& p1, int dq, unsigned W) {
    const float NEG = -__builtin_inff();
#pragma unroll
    for (int r = 0; r < 16; ++r) {
        const int c = (r & 3) + 8 * (r >> 2);
        if ((unsigned)(dq - c) >= W) p0[r] = NEG;
        if ((unsigned)(dq - c - 32) >= W) p1[r] = NEG;
    }
}
__device__ __forceinline__ void partialSM(f32x16& p0, f32x16& p1, float& m_reg, float& mn, float& alpha, bool rs) {
    float pmax = p0[0]; for (int r = 1; r < 16; ++r) pmax = fmaxf(pmax, p0[r]); for (int r = 0; r < 16; ++r) pmax = fmaxf(pmax, p1[r]);
    if (!rs) pmax = -__builtin_inff();
    { auto rr = __builtin_amdgcn_permlane32_swap(__float_as_uint(pmax), __float_as_uint(pmax), false, false);
      pmax = fmaxf(__uint_as_float(rr[0]), __uint_as_float(rr[1])); }
    constexpr float C2 = 1.4426950408889634f * SCALE;
    if (__builtin_expect(__all((pmax - m_reg) * SCALE <= THR), 1)) { mn = m_reg; alpha = 1.f; }
    else { mn = fmaxf(m_reg, pmax); alpha = __builtin_amdgcn_exp2f((m_reg - mn) * C2); m_reg = mn; }
    const float mnL = rs ? -mn * C2 : -__builtin_inff();
    for (int r = 0; r < 16; ++r) p0[r] = fmaf(p0[r], C2, mnL); for (int r = 0; r < 16; ++r) p1[r] = fmaf(p1[r], C2, mnL);
    for (int r = 0; r < 16; ++r) p0[r] = __builtin_amdgcn_exp2f(p0[r]);
}
__device__ __forceinline__ void finishSM(f32x16& p0, f32x16& p1, float alpha, float& l_reg, bf16x8& pa0, bf16x8& pa1, bf16x8& pa2, bf16x8& pa3) {
    for (int r = 0; r < 16; ++r) p1[r] = __builtin_amdgcn_exp2f(p1[r]);
    float ps = 0; for (int r = 0; r < 16; ++r) ps += p0[r]; for (int r = 0; r < 16; ++r) ps += p1[r];
    { auto rr = __builtin_amdgcn_permlane32_swap(__float_as_uint(ps), __float_as_uint(ps), false, false);
      ps = __uint_as_float(rr[0]) + __uint_as_float(rr[1]); }
    l_reg = l_reg * alpha + ps;
#define PK4(P, B_, OUT) do { unsigned a0 = cvtpk(P[B_+0], P[B_+1]), a1 = cvtpk(P[B_+2], P[B_+3]);                          \
        unsigned b0 = cvtpk(P[B_+4], P[B_+5]), b1 = cvtpk(P[B_+6], P[B_+7]);                                             \
        auto r0 = __builtin_amdgcn_permlane32_swap(a0, b0, false, false); auto r1 = __builtin_amdgcn_permlane32_swap(a1, b1, false, false); \
        u32x4 w = {r0[0], r1[0], r0[1], r1[1]}; OUT = *reinterpret_cast<bf16x8*>(&w); } while (0)
    PK4(p0, 0, pa0); PK4(p0, 8, pa1); PK4(p1, 0, pa2); PK4(p1, 8, pa3);
#undef PK4
}
template <int KB>
__device__ __forceinline__ void qkt(f32x16& p0, f32x16& p1, const char* K_lds, int r32, int hi, const bf16x8* qr) {
    p0 = f32x16{}; p1 = f32x16{};
    const char* kb[4];
#pragma unroll
    for (int dd = 0; dd < 4; ++dd) kb[dd] = K_lds + KB * SHM_K + KSWZ(r32, (dd * 16 + hi * 8) * 2);
#pragma unroll
    for (int d0 = 0; d0 < 8; ++d0) { const char* a = kb[d0 & 3] + (d0 >> 2) * 128;
        bf16x8 b0 = *reinterpret_cast<const bf16x8*>(a);
        bf16x8 b1 = *reinterpret_cast<const bf16x8*>(a + 32 * 256);
        p0 = __builtin_amdgcn_mfma_f32_32x32x16_bf16(b0, qr[d0], p0, 0, 0, 0);
        p1 = __builtin_amdgcn_mfma_f32_32x32x16_bf16(b1, qr[d0], p1, 0, 0, 0); }
}
template <int VB>
__device__ __forceinline__ void pv_tile(f32x16* o, int vb0, bf16x8 pa0, bf16x8 pa1, bf16x8 pa2, bf16x8 pa3) {
#define TRRD(dst, off) asm volatile("ds_read_b64_tr_b16 %0, %1 offset:%2" : "=&v"(dst) : "v"(vb0), "i"(off) : "memory")
#define PV_D0(d0) do { s16x4 l0, l1, l2, l3, h0, h1, h2, h3; constexpr int b_ = VB * SHM_V + v_rd_off(d0, 0, 0); \
        TRRD(l0, b_); TRRD(h0, b_ + 2048); TRRD(l1, b_ + 4096); TRRD(h1, b_ + 6144); TRRD(l2, b_ + 8192); TRRD(h2, b_ + 10240); TRRD(l3, b_ + 12288); TRRD(h3, b_ + 14336); \
        asm volatile("s_waitcnt lgkmcnt(0)" ::: "memory"); SBAR();   \
        o[d0] = __builtin_amdgcn_mfma_f32_32x32x16_bf16(pa0, (bf16x8){l0[0], l0[1], l0[2], l0[3], h0[0], h0[1], h0[2], h0[3]}, o[d0], 0, 0, 0);   \
        o[d0] = __builtin_amdgcn_mfma_f32_32x32x16_bf16(pa1, (bf16x8){l1[0], l1[1], l1[2], l1[3], h1[0], h1[1], h1[2], h1[3]}, o[d0], 0, 0, 0);   \
        o[d0] = __builtin_amdgcn_mfma_f32_32x32x16_bf16(pa2, (bf16x8){l2[0], l2[1], l2[2], l2[3], h2[0], h2[1], h2[2], h2[3]}, o[d0], 0, 0, 0);   \
        o[d0] = __builtin_amdgcn_mfma_f32_32x32x16_bf16(pa3, (bf16x8){l3[0], l3[1], l3[2], l3[3], h3[0], h3[1], h3[2], h3[3]}, o[d0], 0, 0, 0); } while (0)
    PV_D0(0); PV_D0(1); PV_D0(2); PV_D0(3);
#undef PV_D0
#undef TRRD
}

struct BlockRef { const bf16* Q; const bf16* K; const bf16* V; bf16* O; const float* km; int P0; int qb; };
struct Seam { bf16x8 qr[8]; bf16x8 st_v0, st_v1, st_k0, st_k1; };

constexpr int KM_LDS_OFF = 69632, KM_PITCH = 272;
__device__ __forceinline__ void stage_kmean(char* lds, const float* km) {
    const int tid = opaque_tid(), row = tid >> 4, chunk = tid & 15;
    const float* kp = km + (row & 15) * 128 + chunk * 8;
    f32x4 a = *(const f32x4*)kp, b = *(const f32x4*)(kp + 4);
    a = a * (1.0f / 256.0f); b = b * (1.0f / 256.0f);
    const bf16x8 h = pack8(a, b);
    f32x4 ah, bh;
#pragma unroll
    for (int j = 0; j < 4; ++j) { ah[j] = __uint_as_float(((unsigned)(unsigned short)h[j]) << 16); bh[j] = __uint_as_float(((unsigned)(unsigned short)h[4 + j]) << 16); }
    const bf16x8 l = pack8(a - ah, b - bh);
    *(bf16x8*)(lds + KM_LDS_OFF + row * KM_PITCH + chunk * 16) = (row >= 16) ? l : h;
}
__device__ __forceinline__ unsigned gate_select(const bf16x8* qr, const char* lds, int qb, int r32, int hi) {
    if (qb <= 3) return (1u << qb) - 1u;
    f32x16 p = {};
    const char* kp = lds + KM_LDS_OFF + r32 * KM_PITCH + hi * 16;
#pragma unroll
    for (int d0 = 0; d0 < 8; ++d0) {
        const bf16x8 frag = *(const bf16x8*)(kp + d0 * 32);
        p = __builtin_amdgcn_mfma_f32_32x32x16_bf16(frag, qr[d0], p, 0, 0, 0);
    }
    float g[16];
#pragma unroll
    for (int r = 0; r < 8; ++r) { const float v = p[r] + p[r + 8];
        auto rr = __builtin_amdgcn_permlane32_swap(__float_as_uint(v), __float_as_uint(v), false, false);
        g[(r & 3) + 8 * (r >> 2)] = __uint_as_float(rr[0]); g[(r & 3) + 8 * (r >> 2) + 4] = __uint_as_float(rr[1]); }
    unsigned sel = 0u;
#pragma unroll
    for (int pass = 0; pass < 3; ++pass) { float best = -__builtin_inff(); int bi = -1;
#pragma unroll
        for (int n = 0; n < 16; ++n) { const bool ok = (n < qb) && !((sel >> n) & 1u) && (g[n] > best); best = ok ? g[n] : best; bi = ok ? n : bi; }
        if (bi >= 0) sel |= 1u << bi; }
    return sel;
}

#define ROW(p, k0, rr) ((p) + (size_t)((k0) + (rr)) * D + sc)
#define VMW() asm volatile("s_waitcnt vmcnt(0)" ::: "memory")
#define VMWN(n) asm volatile("s_waitcnt vmcnt(%0)" :: "i"(n) : "memory")
#define SLOAD_H(Kp, Vp, k0) do { S.st_v0 = load8(ROW(Vp, k0, sr)); S.st_v1 = load8(ROW(Vp, k0, 32 + sr));              \
                         S.st_k0 = load8(ROW(Kp, k0, sr)); S.st_k1 = load8(ROW(Kp, k0, 32 + sr)); } while (0)
#define SWRITE_HK(bf) do { *(bf16x8*)(K_lds + (bf) * SHM_K + kws) = S.st_k0; *(bf16x8*)(K_lds + (bf) * SHM_K + kws + 32 * 256) = S.st_k1; } while (0)
#define SWRITE_HV(bf) do { *(bf16x8*)(V_lds + (bf) * SHM_V + vst0) = S.st_v0; *(bf16x8*)(V_lds + (bf) * SHM_V + vst1) = S.st_v1; } while (0)
#define SWRITE_H(bf) do { SWRITE_HV(bf); SWRITE_HK(bf); } while (0)

__device__ __forceinline__ void moba_prime(const BlockRef& cur, char* lds, Seam& S) {
    const int tid = opaque_tid(), wid = __builtin_amdgcn_readfirstlane(tid >> 6), lane = tid & 63, r32 = lane & 31, hi = lane >> 5;
    const int sr = tid >> 4, sc = (tid & 15) * 8, kws = KSWZ(sr, sc * 2); char* K_lds = lds + 2 * SHM_V;
    for (int d0 = 0; d0 < 8; ++d0) S.qr[d0] = load8(cur.Q + (size_t)(wid * QBLK + r32) * D + d0 * 16 + hi * 8);
    SLOAD_H(cur.K, cur.V, 0); VMW(); SWRITE_HK(0);
    __syncthreads();
}
__device__ __forceinline__ void moba_block(const BlockRef& cur, const BlockRef& nxt, char* lds, Seam& S) {
    const int tid = opaque_tid(), wid = __builtin_amdgcn_readfirstlane(tid >> 6), lane = tid & 63, r32 = lane & 31, hi = lane >> 5;
    const int NT = (cur.qb + 1) * 4;
    constexpr int W = 0x40000000;
    const int qlo = cur.P0 + wid * QBLK, qm = qlo + r32 - 4 * hi;
    char* V_lds = lds; char* K_lds = lds + 2 * SHM_V;
    float* ws = (float*)(lds + 2 * SHM_V + 2 * SHM_K) + wid * 64; float* li_l = ws, * al_l = ws + 32;
    float m_reg = -1e30f, l_reg = 0; f32x16 o[4] = {};
    const int sr = tid >> 4, sc = (tid & 15) * 8, vst0 = v_st(sr, sc), vst1 = v_st(32 + sr, sc), kws = KSWZ(sr, sc * 2);
    const int vb0 = (int)(uintptr_t)V_lds + v_rd_base(lane);
    const bf16* Kh = cur.K; const bf16* Vh = cur.V;
    const int qb = cur.qb;
    const unsigned sel = gate_select(S.qr, lds, qb, r32, hi);
#define RSEL(t) ((((t) >> 2) >= qb) || (((sel >> ((t) >> 2)) & 1u) != 0u))
#define RESC(a) do { if (__any((a) < 1.f)) { if (hi == 0) al_l[r32] = (a); asm volatile("s_waitcnt lgkmcnt(0)" ::: "memory");              \
                     for (int d_ = 0; d_ < 4; ++d_) for (int r = 0; r < 16; ++r) o[d_][r] *= al_l[crow(r, hi)]; } } while (0)
#define KBASE(t) ((t) * KVBLK)
#define MASKT(P0_, P1_, t) do { const int kb_ = KBASE(t); if (kb_ + KVBLK - 1 > qlo) mask_tile(P0_, P1_, qm - kb_, (unsigned)W); } while (0)
    constexpr int NQL = 8;
#define SEAM_K0() do { VMWN(NQL); SWRITE_HK(0); SBAR(); } while (0)
    f32x16 pA0, pA1, pB0, pB1; float mnA, mnB, alA, alB; bf16x8 pa0, pa1, pa2, pa3;
    SWRITE_HV(0); SBAR();
    if (NT > 1) { SLOAD_H(Kh, Vh, KBASE(1)); }
    SBAR(); qkt<0>(pA0, pA1, K_lds, r32, hi, S.qr);
    MASKT(pA0, pA1, 0); partialSM(pA0, pA1, m_reg, mnA, alA, RSEL(0));
    if (NT > 1) { VMW(); SWRITE_H(1); }
    __syncthreads();
#define HALF_STEP(PX0, PX1, mnX, alX, PY0, PY1, alY, t, KB, VB, SB) do {                                                      \
        SBAR(); qkt<KB>(PX0, PX1, K_lds, r32, hi, S.qr);                                                                      \
        finishSM(PY0, PY1, alY, l_reg, pa0, pa1, pa2, pa3); SBAR();                                                           \
        if ((t) + 1 < NT) { SLOAD_H(Kh, Vh, KBASE((t) + 1)); SBAR(); }                                                        \
        pv_tile<VB>(o, vb0, pa0, pa1, pa2, pa3); MASKT(PX0, PX1, (t)); partialSM(PX0, PX1, m_reg, mnX, alX, RSEL(t));         \
        __syncthreads();                                                                                                      \
        if ((t) + 1 < NT) { VMW(); SWRITE_H(SB); }                                                                            \
        RESC(alX); __syncthreads(); } while (0)
    for (int t = 1; t + 1 < NT; t += 2) {
        HALF_STEP(pB0, pB1, mnB, alB, pA0, pA1, alA, t, 1, 0, 0);
        HALF_STEP(pA0, pA1, mnA, alA, pB0, pB1, alB, t + 1, 0, 1, 1);
    }
    const bool even = (NT & 1) == 0;
    if (even) { SBAR(); qkt<1>(pB0, pB1, K_lds, r32, hi, S.qr); SBAR(); }
    SLOAD_H(nxt.K, nxt.V, 0); SBAR();
#pragma unroll
    for (int d0 = 0; d0 < 8; ++d0) S.qr[d0] = load8(nxt.Q + (size_t)(wid * QBLK + r32) * D + d0 * 16 + hi * 8);
    SBAR();
    finishSM(pA0, pA1, alA, l_reg, pa0, pa1, pa2, pa3); SBAR();
    pv_tile<0>(o, vb0, pa0, pa1, pa2, pa3);
    if (even) { MASKT(pB0, pB1, NT - 1); partialSM(pB0, pB1, m_reg, mnB, alB, RSEL(NT - 1)); __syncthreads(); RESC(alB);
        finishSM(pB0, pB1, alB, l_reg, pa0, pa1, pa2, pa3); SBAR(); pv_tile<1>(o, vb0, pa0, pa1, pa2, pa3); }
    SBAR(); SEAM_K0();
    if (hi == 0) li_l[r32] = l_reg; asm volatile("s_waitcnt lgkmcnt(0)" ::: "memory");
    float rli[16];
#pragma unroll
    for (int r = 0; r < 16; ++r) rli[r] = __builtin_amdgcn_rcpf(li_l[crow(r, hi)]);
    bf16* Ow = cur.O + (size_t)(wid * QBLK) * OSTR;
#pragma unroll
    for (int r = 0; r < 16; ++r) { const int orow = crow(r, hi);
#pragma unroll
        for (int d0 = 0; d0 < 4; ++d0) { const float v = o[d0][r] * rli[r];
            const float vn = __shfl_xor(v, 1);
            if ((r32 & 1) == 0) *(unsigned*)(Ow + (size_t)orow * OSTR + d0 * 32 + r32) = cvtpk(v, vn); } }
    __syncthreads();
#undef RSEL
#undef RESC
#undef KBASE
#undef MASKT
#undef SEAM_K0
#undef HALF_STEP
}
#undef ROW
#undef VMW
#undef VMWN
#undef SLOAD_H
#undef SWRITE_HK
#undef SWRITE_HV
#undef SWRITE_H

__device__ __forceinline__ BlockRef moba_ref(int L, int pass, const bf16* Q, const bf16* K, const bf16* V, bf16* O, const float* kmean) {
    const int bh = L >> 3, x = L & 7, qb = pass ? 15 - x : x, b = bh >> 3, h = bh & 7;
    BlockRef r;
    r.Q = Q + ((size_t)bh * 4096 + (size_t)qb * QB) * D; r.K = K + (size_t)bh * 4096 * D; r.V = V + (size_t)bh * 4096 * D;
    r.O = O + ((size_t)b * 4096 + (size_t)qb * QB) * OSTR + h * D; r.km = kmean + (size_t)bh * 16 * 128; r.P0 = qb * QB; r.qb = qb;
    return r;
}
__device__ __forceinline__ void moba_phase(char* lds, const bf16* Q, const bf16* K, const bf16* V, bf16* O, const float* kmean, int vcu, int G) {
    constexpr int total = 256;
    int L = vcu; if (L >= total) return;
    int pass = 0;
    BlockRef cur = moba_ref(L, 0, Q, K, V, O, kmean);
    Seam S;
    stage_kmean(lds, cur.km);
    moba_prime(cur, lds, S);
    for (;;) {
        const bool more_pass = pass == 0, more_item = L + G < total, last = !more_pass && !more_item;
        int passn = pass + 1, Ln = L;
        if (!more_pass) { passn = 0; Ln = more_item ? L + G : L; }
        const BlockRef nxt = last ? cur : moba_ref(Ln, passn, Q, K, V, O, kmean);
        moba_block(cur, nxt, lds, S);
        if (last) break;
        if (passn == 0) { stage_kmean(lds, nxt.km); __syncthreads(); }
        cur = nxt; pass = passn; L = Ln;
    }
}
#undef SBAR
}

constexpr int NWAVES = 8;
constexpr int M = 16384, DM = 1024, SEQ = 4096, FF = 4096;
constexpr size_t MiB = 1u << 20;
constexpr size_t WS_SS = 1 * MiB, WS_ROPE = 3 * MiB, WS_KM = 5 * MiB;
constexpr size_t WS_WQKV = 6 * MiB, WS_WO = 18 * MiB, WS_WPOOL = 22 * MiB, WS_WCI = 23 * MiB, WS_WCO = 29 * MiB, WS_WUP = 31 * MiB, WS_WDN = 63 * MiB;
constexpr size_t WS_XB = 95 * MiB, WS_ACT = 127 * MiB, WS_END = 255 * MiB;
constexpr int LDS_BYTES = 147456;
constexpr int N_PHASES = 22;

#define LAS __attribute__((address_space(3)))
typedef unsigned short bf16;
typedef unsigned v4u __attribute__((ext_vector_type(4)));
typedef unsigned v2u __attribute__((ext_vector_type(2)));
typedef float f32x4 __attribute__((ext_vector_type(4)));
#define LDS_WAIT() asm volatile("s_waitcnt lgkmcnt(0)" ::: "memory")
__device__ __forceinline__ unsigned pk2(float lo, float hi) { return pg8::cvt_pk_bf16(lo, hi); }
__device__ __forceinline__ float bf_lo(unsigned w) { return __uint_as_float(w << 16); }
__device__ __forceinline__ float bf_hi(unsigned w) { return __uint_as_float(w & 0xffff0000u); }

__device__ __forceinline__ float wave_sum(float v) {
#pragma unroll
    for (int o = 1; o < 64; o <<= 1) v += __shfl_xor(v, o);
    return v;
}
constexpr int XP_STRIDE = 65, XP_WAVE_BYTES = 64 * XP_STRIDE * 4;
__device__ __forceinline__ void xpose_item(const float* W, int K, int N, bf16* WT, const float* gain, int cmap, LAS float* scr, int item, int lane) {
    const int nblk = N / 64, kb = item / nblk, nb = item % nblk, k0 = 64 * kb, n0 = 64 * nb;
    const int n4 = (lane & 15) * 4, ks = lane >> 4;
    f32x4 w[16];
#pragma unroll
    for (int i = 0; i < 16; ++i) w[i] = __builtin_nontemporal_load((const f32x4*)(W + (size_t)(k0 + 4 * i + ks) * N + n0 + n4));
    if (gain) {
#pragma unroll
        for (int i = 0; i < 16; ++i) w[i] = w[i] * gain[k0 + 4 * i + ks];
    }
#pragma unroll
    for (int i = 0; i < 16; ++i) { LAS float* d = scr + (4 * i + ks) * XP_STRIDE + n4; d[0] = w[i][0]; d[1] = w[i][1]; d[2] = w[i][2]; d[3] = w[i][3]; }
    LDS_WAIT(); asm volatile("" ::: "memory");
    int r0 = n0;
    if (cmap == 1) { if (n0 < 1024) r0 = 2048 + n0; else if (n0 < 2048) { const int c = n0 - 1024; r0 = (c >> 7) * 256 + (c & 127); } else { const int c = n0 - 2048; r0 = (c >> 7) * 256 + 128 + (c & 127); } }
    const int c = lane & 7;
#pragma unroll
    for (int j = 0; j < 8; ++j) { const int n = (lane >> 3) + 8 * j; const LAS float* sp = scr + (8 * c) * XP_STRIDE + n;
        v4u o; o.x = pk2(sp[0 * XP_STRIDE], sp[1 * XP_STRIDE]); o.y = pk2(sp[2 * XP_STRIDE], sp[3 * XP_STRIDE]); o.z = pk2(sp[4 * XP_STRIDE], sp[5 * XP_STRIDE]); o.w = pk2(sp[6 * XP_STRIDE], sp[7 * XP_STRIDE]);
        *(v4u*)(WT + (size_t)(r0 + n) * K + k0 + 8 * c) = o; }
    LDS_WAIT(); asm volatile("" ::: "memory");
}

#define XB_TMO      128
#define XB_XCNT(j)  (256  + 64 * (j))
#define XB_XSUB(j)  (1280 + 64 * (j))
#define XB_XGEN(j)  (2304 + 64 * (j))
#define XB_TOP      3328
#define XB_TOPGEN   3392
#define XCD_BAR_WORDS 3456
#define XB_SPIN_CAP (1u << 18)
__device__ __forceinline__ unsigned xb_ld(unsigned* p)              { return __hip_atomic_load(p, __ATOMIC_RELAXED, __HIP_MEMORY_SCOPE_AGENT); }
__device__ __forceinline__ unsigned xb_add(unsigned* p, unsigned v) { return __hip_atomic_fetch_add(p, v, __ATOMIC_RELAXED, __HIP_MEMORY_SCOPE_AGENT); }
__device__ __forceinline__ unsigned xb_xcc_id() { return (unsigned)__builtin_amdgcn_s_getreg((3 << 11) | 20) & 0xFu; }
#define XB_SPIN(cond, bar) do { unsigned _sp = 0; while (cond) { __builtin_amdgcn_s_sleep(1); \
    if ((++_sp & 255u) == 0u) { if (xb_ld(&(bar)[XB_TMO])) break; if (_sp > XB_SPIN_CAP) { atomicAdd(&(bar)[XB_TMO], 1u); break; } } } } while (0)
struct XcdBarrier { unsigned* bar; unsigned x; volatile LAS unsigned* st; };
__device__ __forceinline__ XcdBarrier xcd_barrier_post(unsigned* bar, volatile LAS unsigned* st) {
    XcdBarrier b; b.bar = bar; b.x = xb_xcc_id(); b.st = st;
    if (threadIdx.x == 0) (void)xb_add(&bar[XB_XCNT(b.x)], 1u);
    return b;
}
__device__ __forceinline__ void xcd_barrier_complete(unsigned* bar, unsigned x, unsigned& nloc, unsigned& nx) {
    const unsigned G = gridDim.x * gridDim.y * gridDim.z;
    unsigned sum, cnt, mine, sp = 0u;
    for (;;) {
        sum = 0u; cnt = 0u; mine = 0u;
#pragma unroll
        for (unsigned j = 0; j < 16; ++j) { const unsigned c = xb_ld(&bar[XB_XCNT(j)]); sum += c; cnt += (c > 0u) ? 1u : 0u; mine = (j == x) ? c : mine; }
        if (sum == G) break;
        __builtin_amdgcn_s_sleep(1);
        if ((++sp & 255u) == 0u) { if (xb_ld(&bar[XB_TMO])) break; if (sp > XB_SPIN_CAP) { atomicAdd(&bar[XB_TMO], 1u); break; } }
    }
    nloc = mine > 0u ? mine : 1u; nx = cnt > 0u ? cnt : 1u;
}
__device__ __forceinline__ void xcd_barrier(const XcdBarrier& b) {
    asm volatile("s_waitcnt vmcnt(0)" ::: "memory");
    __syncthreads();
    if (threadIdx.x == 0) {
        unsigned* bar = b.bar;
        __builtin_amdgcn_s_waitcnt(0);
        unsigned nloc = b.st[0], nx = b.st[1];
        if (nloc == 0u) { xcd_barrier_complete(bar, b.x, nloc, nx); b.st[0] = nloc; b.st[1] = nx; }
        const unsigned old = xb_add(&bar[XB_XSUB(b.x)], 1u);
        const unsigned gen = old / nloc;
        if (old + 1u == (gen + 1u) * nloc) {
            __builtin_amdgcn_fence(__ATOMIC_RELEASE, "agent");
            asm volatile("s_waitcnt vmcnt(0)" ::: "memory");
            const unsigned og = xb_add(&bar[XB_TOP], 1u);
            const unsigned tg = og / nx;
            if (og + 1u == (tg + 1u) * nx) xb_add(&bar[XB_TOPGEN], 1u);
            else XB_SPIN(xb_ld(&bar[XB_TOPGEN]) == tg, bar);
            __builtin_amdgcn_fence(__ATOMIC_ACQUIRE, "agent");
            xb_add(&bar[XB_XGEN(b.x)], 1u);
            asm volatile("s_waitcnt vmcnt(0)" ::: "memory");
        } else {
            XB_SPIN(xb_ld(&bar[XB_XGEN(b.x)]) == gen, bar);
            __builtin_amdgcn_fence(__ATOMIC_ACQUIRE, "agent");
            asm volatile("s_waitcnt vmcnt(0)" ::: "memory");
        }
    }
    __syncthreads();
}

struct Args { const float* in[14]; float* out; unsigned char* ws; int ph_lo, ph_hi; };

__device__ __forceinline__ void prologue(const Args& a, LAS unsigned char* lds, int vcu, int G, int wave, int lane, int tid) {
    unsigned char* ws = a.ws;
    LAS float* scr = (LAS float*)(lds + wave * XP_WAVE_BYTES);
    const int gw = vcu * NWAVES + wave, NGW = G * NWAVES;
    constexpr int I_QKV = 16 * 48, I_SQ = 16 * 16, I_POOL = 4 * 4, I_UP = 16 * 64, I_DN = 64 * 16;
    constexpr int NITEMS = 2 * I_QKV + 2 * I_SQ + 4 * I_POOL + I_QKV + I_SQ + 4 * I_UP + 4 * I_DN;
    const float* nmix = a.in[2]; const float* nmlp = a.in[3];
    for (int it = gw; it < NITEMS; it += NGW) {
        int r = it;
        if (r < 2 * I_QKV) { const int l = r / I_QKV; r -= l * I_QKV; xpose_item(a.in[4] + (size_t)l * 1024 * 3072, 1024, 3072, (bf16*)(ws + WS_WQKV) + (size_t)l * 3072 * 1024, nmix + (l ? 3 : 0) * 1024, 0, scr, r, lane); continue; } r -= 2 * I_QKV;
        if (r < 2 * I_SQ) { const int l = r / I_SQ; r -= l * I_SQ; xpose_item(a.in[5] + (size_t)l * 1024 * 1024, 1024, 1024, (bf16*)(ws + WS_WO) + (size_t)l * 1024 * 1024, nullptr, 0, scr, r, lane); continue; } r -= 2 * I_SQ;
        if (r < 4 * I_POOL) { const int g = r / I_POOL; r -= g * I_POOL; xpose_item(a.in[6] + (size_t)g * 65536, 256, 256, (bf16*)(ws + WS_WPOOL) + (size_t)g * 65536, nullptr, 0, scr, r, lane); continue; } r -= 4 * I_POOL;
        if (r < I_QKV) { xpose_item(a.in[8], 1024, 3072, (bf16*)(ws + WS_WCI), nmix + 2 * 1024, 1, scr, r, lane); continue; } r -= I_QKV;
        if (r < I_SQ) { xpose_item(a.in[10], 1024, 1024, (bf16*)(ws + WS_WCO), nullptr, 0, scr, r, lane); continue; } r -= I_SQ;
        if (r < 4 * I_UP) { const int l = r / I_UP; r -= l * I_UP; xpose_item(a.in[11] + (size_t)l * 1024 * 4096, 1024, 4096, (bf16*)(ws + WS_WUP) + (size_t)l * 4096 * 1024, nmlp + l * 1024, 0, scr, r, lane); continue; } r -= 4 * I_UP;
        { const int l = r / I_DN; r -= l * I_DN; xpose_item(a.in[12] + (size_t)l * 4096 * 1024, 4096, 1024, (bf16*)(ws + WS_WDN) + (size_t)l * 1024 * 4096, nullptr, 3, scr, r, lane); }
    }
    {   const float* x = a.in[0]; bf16* xb = (bf16*)(ws + WS_XB); float* ss = (float*)(ws + WS_SS);
        for (int m0 = gw; m0 < M; m0 += 2 * NGW) {
            f32x4 v[2][4]; float sq[2];
#pragma unroll
            for (int u = 0; u < 2; ++u) { const int m = m0 + u * NGW; const f32x4* xr = (const f32x4*)(x + (size_t)(m < M ? m : m0) * DM) + lane;
#pragma unroll
                for (int j = 0; j < 4; ++j) v[u][j] = __builtin_nontemporal_load(xr + 64 * j); }
#pragma unroll
            for (int u = 0; u < 2; ++u) { float s = 0.f;
#pragma unroll
                for (int j = 0; j < 4; ++j) s += (v[u][j][0] * v[u][j][0] + v[u][j][1] * v[u][j][1]) + (v[u][j][2] * v[u][j][2] + v[u][j][3] * v[u][j][3]);
                sq[u] = wave_sum(s); }
#pragma unroll
            for (int u = 0; u < 2; ++u) { const int m = m0 + u * NGW; if (m < M) {
                v2u* o8 = (v2u*)(xb + (size_t)m * DM) + lane;
#pragma unroll
                for (int j = 0; j < 4; ++j) { v2u w; w.x = pk2(v[u][j][0], v[u][j][1]); w.y = pk2(v[u][j][2], v[u][j][3]); o8[64 * j] = w; }
                if (lane < 16) ss[(size_t)m * 16 + lane] = (lane == 0) ? sq[u] : 0.f; } }
        }
    }
    {   const int gt = vcu * 512 + tid, NT = G * 512;
        const int* pos = (const int*)a.in[1]; float* rope = (float*)(ws + WS_ROPE);
        const float invf[16] = {1.0f, 0.44036659598350525f, 0.1939227432012558f, 0.08539710193872452f, 0.03760603070259094f, 0.016560440883040428f, 0.007292664609849453f, 0.0032114461064338684f,
                                0.0014142135623842478f, 0.0006227724370546639f, 0.00027424818836152554f, 0.00012076973507646471f, 5.3182957344688475e-05f, 2.34199997066753e-05f, 1.0313385246263351e-05f, 4.541670477919979e-06f};
        for (int i = gt; i < M * 16; i += NT) { const int row = i >> 4, f = i & 15;
            float fr = invf[0];
#pragma unroll
            for (int q = 1; q < 16; ++q) fr = (f == q) ? invf[q] : fr;
            const float ang = (float)pos[row] * fr;
            const double ad = (double)ang; const double k = __builtin_rint(ad * 0.15915494309189535); const float rf = (float)(ad - k * 6.283185307179586);
            rope[(size_t)row * 32 + f] = __cosf(rf); rope[(size_t)row * 32 + 16 + f] = __sinf(rf); }
        float* km = (float*)(ws + WS_KM);
        for (int i = gt; i < 2 * 65536; i += NT) km[i] = 0.f;
    }
}

__device__ __forceinline__ f32x4 ld4bf(const bf16* p) { const v2u w = *(const v2u*)p; return (f32x4){bf_lo(w.x), bf_hi(w.x), bf_lo(w.y), bf_hi(w.y)}; }
__device__ __forceinline__ void pool_prep(const bf16* X, const float* ss, const float* gain, bf16* PB, LAS unsigned char* lds, int vcu, int G, int tid) {
    LAS float* rsl = (LAS float*)lds;
    for (int chunk = vcu; chunk < M / 64; chunk += G) {
        const int r0 = chunk * 64, bstart = r0 & ~(SEQ - 1);
        __syncthreads();
        if (tid < 80) { const int row = r0 - 16 + tid; rsl[tid] = (row >= bstart) ? pg8::row_rstd(ss, row) : 0.f; }
        __syncthreads();
        const int q = tid & 255, half = tid >> 8, w = 2 << (q >> 6);
        const f32x4 gn = *(const f32x4*)(gain + 4 * q);
        const int ra = r0 + 32 * half;
        const bf16* xp = X + 4 * q;
        f32x4 S = {0.f, 0.f, 0.f, 0.f};
#pragma unroll
        for (int j = 1; j <= 16; ++j) { const int row = ra - j; if (j <= w && row >= bstart) S += ld4bf(xp + (size_t)row * DM) * rsl[row - r0 + 16]; }
#pragma unroll 8
        for (int i = 0; i < 32; ++i) { const int row = ra + i, t = row - bstart;
            const f32x4 xn = ld4bf(xp + (size_t)row * DM) * rsl[row - r0 + 16];
            f32x4 old = {0.f, 0.f, 0.f, 0.f};
            if (t >= w) old = ld4bf(xp + (size_t)(row - w) * DM) * rsl[row - w - r0 + 16];
            S = S + xn - old;
            const int cnt = (t + 1 < w) ? t + 1 : w;
            const f32x4 p = (S * (1.0f / (float)cnt) - xn) * gn;
            v2u o; o.x = pk2(p[0], p[1]); o.y = pk2(p[2], p[3]); *(v2u*)(PB + (size_t)row * DM + 4 * q) = o; }
    }
}
__device__ __forceinline__ void conv_prep(const bf16* Z, const bf16* GB, const float* cw, bf16* A2, int vcu, int G, int tid) {
    const int gt = vcu * 512 + tid, NT = G * 512;
    for (int it = gt; it < (M / 16) * 128; it += NT) { const int c8 = (it & 127) * 8, rb = (it >> 7) * 16, t0 = rb & (SEQ - 1);
        f32x4 w0[2], w1[2], w2[2];
#pragma unroll
        for (int k = 0; k < 2; ++k) { w0[k] = *(const f32x4*)(cw + c8 + 4 * k); w1[k] = *(const f32x4*)(cw + 1024 + c8 + 4 * k); w2[k] = *(const f32x4*)(cw + 2048 + c8 + 4 * k); }
        const v4u zero = {0u, 0u, 0u, 0u};
        v4u z0 = (t0 >= 2) ? *(const v4u*)(Z + (size_t)(rb - 2) * DM + c8) : zero;
        v4u z1 = (t0 >= 1) ? *(const v4u*)(Z + (size_t)(rb - 1) * DM + c8) : zero;
        v4u zz[16], gg[16];
#pragma unroll
        for (int i = 0; i < 16; ++i) { zz[i] = *(const v4u*)(Z + (size_t)(rb + i) * DM + c8); gg[i] = *(const v4u*)(GB + (size_t)(rb + i) * DM + c8); }
#pragma unroll
        for (int i = 0; i < 16; ++i) { const v4u z2 = zz[i], gb = gg[i]; v4u o;
#pragma unroll
            for (int k = 0; k < 4; ++k) { const int e = 2 * k;
                const float a = bf_lo(gb[k]) * (w0[e >> 2][e & 3] * bf_lo(z0[k]) + w1[e >> 2][e & 3] * bf_lo(z1[k]) + w2[e >> 2][e & 3] * bf_lo(z2[k]));
                const float b = bf_hi(gb[k]) * (w0[(e + 1) >> 2][(e + 1) & 3] * bf_hi(z0[k]) + w1[(e + 1) >> 2][(e + 1) & 3] * bf_hi(z1[k]) + w2[(e + 1) >> 2][(e + 1) & 3] * bf_hi(z2[k]));
                o[k] = pk2(a, b); }
            *(v4u*)(A2 + (size_t)(rb + i) * DM + c8) = o; z0 = z1; z1 = z2; }
    }
}
__device__ __forceinline__ void final_norm(const bf16* X, const float* g, float* out, int vcu, int G, int wave, int lane) {
    const int gw = vcu * NWAVES + wave, NGW = G * NWAVES;
    f32x4 gv[4];
#pragma unroll
    for (int j = 0; j < 4; ++j) gv[j] = ((const f32x4*)g)[lane + 64 * j];
    for (int m0 = gw; m0 < M; m0 += 2 * NGW) {
        f32x4 v[2][4]; float rs[2];
#pragma unroll
        for (int u = 0; u < 2; ++u) { const int m = m0 + u * NGW; const bf16* xr = X + (size_t)(m < M ? m : m0) * DM + 4 * lane;
#pragma unroll
            for (int j = 0; j < 4; ++j) v[u][j] = ld4bf(xr + 256 * j); }
#pragma unroll
        for (int u = 0; u < 2; ++u) { float s = 0.f;
#pragma unroll
            for (int j = 0; j < 4; ++j) s += (v[u][j][0] * v[u][j][0] + v[u][j][1] * v[u][j][1]) + (v[u][j][2] * v[u][j][2] + v[u][j][3] * v[u][j][3]);
            s = wave_sum(s); rs[u] = 1.0f / sqrtf(s * (1.0f / 1024.0f) + 1e-6f); }
#pragma unroll
        for (int u = 0; u < 2; ++u) { const int m = m0 + u * NGW; if (m < M) { f32x4* o = (f32x4*)(out + (size_t)m * DM) + lane;
#pragma unroll
            for (int j = 0; j < 4; ++j) o[64 * j] = v[u][j] * rs[u] * gv[j]; } }
    }
}

__global__ void __launch_bounds__(NWAVES * 64, 2) trunk_fwd(Args args) {
    extern __shared__ __attribute__((aligned(16))) unsigned char lds_raw[];
    LAS unsigned char* lds = (LAS unsigned char*)lds_raw;
    const int Gk = gridDim.x, bx = blockIdx.x;
    const int vcu = (Gk % 8 == 0) ? (bx % 8) * (Gk / 8) + bx / 8 : bx;
    unsigned char* ws = args.ws;
    float* X = args.out;
    bf16* XB = (bf16*)(ws + WS_XB);
    float* SS = (float*)(ws + WS_SS);
    const float* ROPE = (const float*)(ws + WS_ROPE);
    bf16* ACT0 = (bf16*)(ws + WS_ACT);
    bf16* ACT1 = ACT0 + (size_t)M * DM;
    bf16* ACT2 = ACT1 + (size_t)M * DM;
    bf16* ACT3 = ACT2 + (size_t)M * DM;
#define SSBUF(k) (SS + (size_t)((k) & 1) * M * 16)
    volatile LAS unsigned* MISC = (volatile LAS unsigned*)(lds + 147200);
    if (threadIdx.x < 32) MISC[threadIdx.x] = 0u;
    __syncthreads();
    XcdBarrier bar; bar.bar = (unsigned*)ws; bar.x = 0; bar.st = MISC + 8;
    if (args.ph_hi - args.ph_lo > 1) bar = xcd_barrier_post((unsigned*)ws, MISC + 8);

    int probe_state = 0;
    for (int ph = args.ph_lo; ph < args.ph_hi; ++ph) {
        if (ph == 8) continue;
        const int tid = opaque_tid(), lane = tid & 63, wave = __builtin_amdgcn_readfirstlane(tid >> 6);
        int Gp = Gk; asm volatile("" : "+s"(Gp));
        const int G = Gp;
        if (ph == 0) {
            if (PM & 1) prologue(args, lds, vcu, G, wave, lane, tid);
        } else if (ph == N_PHASES - 1) {
            final_norm(XB, args.in[13], X, vcu, G, wave, lane);
        } else {
            const int l = (ph - 1) / 5, s = (ph - 1) % 5, kind = l % 3;
            const int li = (l == 3) ? 1 : 0;
            if (s == 3) {
                pg8::Gemm g{XB, (const bf16*)(ws + WS_WUP) + (size_t)l * FF * DM, M, FF, DM, DM, DM, 0, 0};
                pg8::StaticOrder S; S.init(M, FF, G, bx);
                pg8::EpiUp E{ACT0, SSBUF(2 * l + 1), (LAS float*)(lds + 135168)};
                if (PM & 2) pg8::gemm_phase<pg8::EpiUp>(lds, g, S, E);
            } else if (s == 4 || s == 2 || (s == 1 && kind == 1)) {
                pg8::Gemm g; pg8::EpiRes E; bool run = true;
                E.Xin32 = nullptr; E.xb = XB; E.cscale = nullptr;
                if (s == 4) { g = pg8::Gemm{ACT0, (const bf16*)(ws + WS_WDN) + (size_t)l * DM * FF, M, DM, FF, FF, FF, 0, 1}; E.ssout = SSBUF(2 * l + 2); }
                else {
                    E.ssout = SSBUF(2 * l + 1);
                    if (kind == 0) g = pg8::Gemm{ACT3, (const bf16*)(ws + WS_WO) + (size_t)li * DM * DM, M, DM, DM, DM, DM, 0, 0};
                    else if (kind == 1) { if (s == 1) { g = pg8::Gemm{ACT0, (const bf16*)(ws + WS_WPOOL), M, DM, 256, DM, 256, 256, 0}; E.cscale = args.in[7]; } else run = false; }
                    else g = pg8::Gemm{ACT2, (const bf16*)(ws + WS_WCO), M, DM, DM, DM, DM, 0, 0};
                }
                if (PROBE_REPEAT >= 0 && probe_state == 1) { E.xb = (bf16*)args.out; E.ssout = args.out + 8 * 1024 * 1024; E.Xin32 = nullptr; }
                if (run) { pg8::StaticOrder S; S.init(M, DM, G, bx); if (PM & 4) pg8::gemm_phase<pg8::EpiRes>(lds, g, S, E); }
            } else if (s == 0) {
                if (kind == 0) {
                    pg8::Gemm g{XB, (const bf16*)(ws + WS_WQKV) + (size_t)li * 3072 * DM, M, 3072, DM, DM, DM, 0, 0};
                    pg8::StaticOrder S; S.init(M, 3072, G, bx);
                    pg8::EpiQKV E{ACT0, (size_t)M * DM, SSBUF(2 * l), ROPE, (PROBE_REPEAT >= 0 && probe_state == 1) ? args.out : (float*)(ws + WS_KM) + (size_t)li * 65536, (LAS float*)(lds + 135168)};
                    if (PM & 8) pg8::gemm_phase<pg8::EpiQKV>(lds, g, S, E);
                } else if (kind == 1) {
                    if (PM & 64) pool_prep(XB, SSBUF(2 * l), args.in[2] + l * 1024, ACT0, lds, vcu, G, tid);
                } else {
                    pg8::Gemm g{XB, (const bf16*)(ws + WS_WCI), M, 3072, DM, DM, DM, 0, 0};
                    pg8::StaticOrder S; S.init(M, 3072, G, bx);
                    pg8::EpiConvIn E{ACT0, ACT1, SSBUF(2 * l), (LAS float*)(lds + 135168)};
                    if (PM & 16) pg8::gemm_phase<pg8::EpiConvIn>(lds, g, S, E);
                }
            } else {
                if (kind == 0) { if (PM & 32) att::moba_phase((char*)lds_raw, ACT0, ACT1, ACT2, ACT3, (const float*)(ws + WS_KM) + (size_t)li * 65536, vcu, G); }
                else if (PM & 64) conv_prep(ACT0, ACT1, args.in[9], ACT2, vcu, G, tid);
            }
        }
        if (ph + 1 < args.ph_hi) xcd_barrier(bar);
        if (PROBE_REPEAT >= 0) { if (ph == PROBE_REPEAT && probe_state == 0) { probe_state = 1; --ph; } else if (probe_state == 1) probe_state = 2; }
    }
#undef SSBUF
}

extern "C" void kernel_launch(void* const* d_in, const int* in_sizes, int n_in, void* d_out, int out_size, void* d_ws, size_t ws_size, hipStream_t stream) {
    static int grid = 0;
    if (grid == 0) {
        if (n_in != 14 || in_sizes[0] != M * DM || out_size != M * DM || ws_size < WS_END) { fprintf(stderr, "kernel_launch: unexpected shapes (n_in %d, in0 %d, out %d, ws %zu)\n", n_in, n_in > 0 ? in_sizes[0] : -1, out_size, ws_size); grid = -1; return; }
        int dev = 0, cus = 0, per_cu = 0;
        (void)hipGetDevice(&dev);
        if (hipDeviceGetAttribute(&cus, hipDeviceAttributeMultiprocessorCount, dev) != hipSuccess || cus <= 0) cus = 256;
        if (hipFuncSetAttribute((const void*)trunk_fwd, hipFuncAttributeMaxDynamicSharedMemorySize, LDS_BYTES) != hipSuccess) { fprintf(stderr, "kernel_launch: hipFuncSetAttribute failed\n"); grid = -1; return; }
        if (hipOccupancyMaxActiveBlocksPerMultiprocessor(&per_cu, (const void*)trunk_fwd, NWAVES * 64, LDS_BYTES) != hipSuccess || per_cu < 1) { fprintf(stderr, "kernel_launch: occupancy query says %d blocks per CU\n", per_cu); per_cu = 1; }
        (void)hipGetLastError();
        grid = cus;
        if (grid > 256) grid = 256;
    }
    if (grid < 0) return;
    Args a{};
    for (int i = 0; i < 14; ++i) a.in[i] = (const float*)d_in[i];
    a.out = (float*)d_out; a.ws = (unsigned char*)d_ws;
#if MK_ONE_LAUNCH
    (void)hipMemsetAsync(d_ws, 0, 16384, stream);
    a.ph_lo = 0; a.ph_hi = N_PHASES;
    void* kargs[] = {&a};
    hipError_t e = hipLaunchCooperativeKernel((const void*)trunk_fwd, dim3(grid), dim3(NWAVES * 64), kargs, LDS_BYTES, stream);
    if (e != hipSuccess) fprintf(stderr, "kernel_launch: cooperative launch failed: %s (grid %d)\n", hipGetErrorString(e), grid);
#else
    for (int ph = 0; ph < N_PHASES; ++ph) {
        if (ph == 8) continue;
        a.ph_lo = ph; a.ph_hi = ph + 1;
        hipLaunchKernelGGL(trunk_fwd, dim3(grid), dim3(NWAVES * 64), LDS_BYTES, stream, a);
    }
#endif
}
```

```cpp
#include <hip/hip_runtime.h>
#include <hip/hip_bf16.h>
#include <hip/hip_cooperative_groups.h>
#include <cstdio>
#include <cstdint>
namespace cg = cooperative_groups;

#ifndef PM
#define PM 0xff
#endif
#ifndef PROBE_REPEAT
#define PROBE_REPEAT -1
#endif
#ifndef MK_ONE_LAUNCH
#define MK_ONE_LAUNCH 1
#endif

__device__ __forceinline__ int opaque_tid() { int t = threadIdx.x; asm volatile("" : "+v"(t)); return t; }
namespace pg8 {
#define PG8_LAS __attribute__((address_space(3)))
typedef unsigned short bf16_t;
typedef short bf16x8 __attribute__((ext_vector_type(8)));
typedef float f32x4 __attribute__((ext_vector_type(4)));
typedef unsigned u32x4 __attribute__((ext_vector_type(4)));
typedef unsigned u32x2 __attribute__((ext_vector_type(2)));
constexpr int BM = 256, BK = 64, HALF = 128, HTB = HALF * BK * 2, STAGE_BYTES = 8 * HTB, NXCD = 8, WGM = 8;

__host__ __device__ __forceinline__ int lds_byte(int r, int c) { const int st = (r >> 4) * 2 + (c >> 5), rr = r & 15, cc = c & 31, ob = rr * 64 + cc * 2; return st * 1024 + (ob ^ (((ob >> 9) & 1) << 5)); }
__host__ __device__ __forceinline__ void stage_rc(int b, int& R, int& C) { const int st = b / 1024, sb = b % 1024, swz = sb ^ (((sb >> 9) & 1) << 5); R = (st >> 1) * 16 + swz / 64; C = (st & 1) * 32 + (swz % 64) / 2; }
__host__ __device__ __forceinline__ int perm32(int rho) { const int n = rho >> 4, i = rho & 15; return 8 * (i >> 2) + 4 * n + (i & 3); }

struct Unit { int pm, pn; };
struct Gemm { const bf16_t* A; const bf16_t* Bt; int M, N, K, lda, ldb, a_pn, tiled; };

struct StaticOrder {
    int nM, nN, nwg, G, c;
    __host__ __device__ void init(int M, int N, int G_, int c_) { nM = M / BM; nN = N / BM; nwg = nM * nN; G = G_; c = c_; }
    __host__ __device__ bool next(int i, Unit& u) const {
        const long L = (long)i * G + c; if (L >= nwg) return false;
        int wgid = (int)L; { const int q = nwg / NXCD, r = nwg % NXCD, xcd = wgid % NXCD, off = wgid / NXCD; wgid = (xcd < r ? xcd * (q + 1) : r * (q + 1) + (xcd - r) * q) + off; }
        const int nig = WGM * nN, gid = wgid / nig, fm = gid * WGM, gsz = (nM - fm) < WGM ? (nM - fm) : WGM;
        u.pm = fm + ((wgid % nig) % gsz); u.pn = (wgid % nig) / gsz; return true;
    }
};

__device__ __forceinline__ unsigned cvt_pk_bf16(float lo, float hi) { unsigned r; asm volatile("v_cvt_pk_bf16_f32 %0, %1, %2" : "=v"(r) : "v"(lo), "v"(hi)); return r; }
__device__ __forceinline__ u32x4 pack8(f32x4 a, f32x4 b) { u32x4 w; w.x = cvt_pk_bf16(a[0], a[1]); w.y = cvt_pk_bf16(a[2], a[3]); w.z = cvt_pk_bf16(b[0], b[1]); w.w = cvt_pk_bf16(b[2], b[3]); return w; }

__device__ __forceinline__ float row_rstd(const float* ss, int row) {
    const f32x4* p = (const f32x4*)(ss + (size_t)row * 16);
    const f32x4 a = p[0], b = p[1], c = p[2], d = p[3];
    const float s = (((a[0] + a[1]) + (a[2] + a[3])) + ((b[0] + b[1]) + (b[2] + b[3]))) + (((c[0] + c[1]) + (c[2] + c[3])) + ((d[0] + d[1]) + (d[2] + d[3])));
    return __builtin_amdgcn_rsqf(s * (1.0f / 1024.0f) + 1e-6f);
}


struct RstdIni { f32x4 a, b; };
__device__ __forceinline__ void rstd_load(const float* ss, RstdIni& ini, int pm) {
    const int tid = opaque_tid();
    const f32x4* q = (const f32x4*)(ss + (size_t)(pm * BM + (tid >> 1)) * 16 + (tid & 1) * 8);
    ini.a = q[0]; ini.b = q[1];
}
__device__ __forceinline__ void rstd_store(PG8_LAS float* tab, const RstdIni& ini, int par) {
    const int tid = opaque_tid();
    float s = ((ini.a[0] + ini.a[1]) + (ini.a[2] + ini.a[3])) + ((ini.b[0] + ini.b[1]) + (ini.b[2] + ini.b[3]));
    s += __shfl_xor(s, 1);
    if (!(tid & 1)) tab[par * BM + (tid >> 1)] = __builtin_amdgcn_rsqf(s * (1.0f / 1024.0f) + 1e-6f);
}
__device__ __forceinline__ void rstd_read(PG8_LAS float* tab, int par, int wr, int fr, float (&rs)[2][4]) {
#pragma unroll
    for (int ai = 0; ai < 2; ++ai)
#pragma unroll
        for (int m = 0; m < 4; ++m) rs[ai][m] = tab[par * BM + ai * HALF + wr * 64 + m * 16 + fr];
}
#define PG8_ZERO_ACC(acc) do { _Pragma("unroll") for (int a_ = 0; a_ < 2; ++a_) _Pragma("unroll") for (int b_ = 0; b_ < 2; ++b_) _Pragma("unroll") for (int m_ = 0; m_ < 4; ++m_) _Pragma("unroll") for (int n_ = 0; n_ < 2; ++n_) \
    acc[a_][b_][m_][n_] = (f32x4){0.f, 0.f, 0.f, 0.f}; } while (0)
#define PG8_RSTD_HOOKS \
    typedef RstdIni Ini; \
    __device__ __forceinline__ void init_load(f32x4 (&acc)[2][2][4][2], Ini& ini, const Unit& u, int, int, int, int) const { PG8_ZERO_ACC(acc); rstd_load(ss, ini, u.pm); } \
    __device__ __forceinline__ void init_apply(f32x4 (&)[2][2][4][2], const Ini& ini, const Unit&, int, int, int, int, int par) const { rstd_store(tab, ini, par); } \
    __device__ __forceinline__ void next_load(Ini& ini, const Unit& nx) const { rstd_load(ss, ini, nx.pm); } \
    __device__ __forceinline__ void next_apply(f32x4 (&acc)[2][2][4][2], Ini& ini, const Unit&, int, int, int, int, int par) const { PG8_ZERO_ACC(acc); rstd_store(tab, ini, par); }

struct EpiUp {
    static constexpr bool PERM = true;
    bf16_t* H; const float* ss; PG8_LAS float* tab;
    PG8_RSTD_HOOKS
    __device__ __forceinline__ void operator()(const f32x4 (&acc)[2][2][4][2], const Unit& u, int wr, int wc, int fr, int fq, int par) const {
        const int row0 = u.pm * BM + wr * 64 + fr, col0 = u.pn * BM + wc * 32 + 8 * fq;
        float rsv[2][4]; rstd_read(tab, par, wr, fr, rsv);
#pragma unroll
        for (int ai = 0; ai < 2; ++ai)
#pragma unroll
            for (int m = 0; m < 4; ++m) { const float rs = rsv[ai][m];
                bf16_t* rowp = H + ((size_t)(u.pm * 64 + u.pn * 4 + wc) * 256 + (ai * HALF + wr * 64 + m * 16 + fr)) * 64 + 8 * fq;
#pragma unroll
                for (int bj = 0; bj < 2; ++bj) { f32x4 v0 = acc[ai][bj][m][0] * rs, v1 = acc[ai][bj][m][1] * rs;
#pragma unroll
                    for (int j = 0; j < 4; ++j) { const float a = fmaxf(v0[j], 0.f), b = fmaxf(v1[j], 0.f); v0[j] = a * a; v1[j] = b * b; }
                    *(u32x4*)(rowp + bj * 32) = pack8(v0, v1); } }
    }
};

struct EpiRes {
    static constexpr bool PERM = true;
    const float* Xin32; bf16_t* xb; float* ssout; const float* cscale;
    struct Ini { u32x4 x[2][4][2]; };
    __device__ __forceinline__ void init_load(f32x4 (&acc)[2][2][4][2], Ini& ini, const Unit& u, int wr, int wc, int fr, int fq) const {
        const int row0 = u.pm * BM + wr * 64 + fr, col0 = u.pn * BM + wc * 64 + 8 * fq;
#pragma unroll
        for (int ai = 0; ai < 2; ++ai)
#pragma unroll
            for (int m = 0; m < 4; ++m)
#pragma unroll
                for (int bj = 0; bj < 2; ++bj) ini.x[ai][m][bj] = *(const u32x4*)(xb + (size_t)(row0 + ai * HALF + m * 16) * 1024 + col0 + bj * 32);
    }
    __device__ __forceinline__ void next_load(Ini&, const Unit&) const {}
    __device__ __forceinline__ void next_apply(f32x4 (&acc)[2][2][4][2], Ini& ini, const Unit& u, int wr, int wc, int fr, int fq, int par) const { init_load(acc, ini, u, wr, wc, fr, fq); init_apply(acc, ini, u, wr, wc, fr, fq, par); }
    __device__ __forceinline__ void init_apply(f32x4 (&acc)[2][2][4][2], const Ini& ini, const Unit& u, int wr, int wc, int fr, int fq, int) const {
        const int col0 = u.pn * BM + wc * 64 + 8 * fq;
        f32x4 is[2][2];
#pragma unroll
        for (int bj = 0; bj < 2; ++bj)
#pragma unroll
            for (int n = 0; n < 2; ++n) { is[bj][n] = (f32x4){1.f, 1.f, 1.f, 1.f};
                if (cscale) { const f32x4 sc = *(const f32x4*)(cscale + col0 + bj * 32 + 4 * n);
#pragma unroll
                    for (int j = 0; j < 4; ++j) is[bj][n][j] = __builtin_amdgcn_rcpf(sc[j]); } }
#pragma unroll
        for (int ai = 0; ai < 2; ++ai)
#pragma unroll
            for (int m = 0; m < 4; ++m)
#pragma unroll
                for (int bj = 0; bj < 2; ++bj) { const u32x4 w = ini.x[ai][m][bj];
                    acc[ai][bj][m][0] = (f32x4){__uint_as_float(w.x << 16), __uint_as_float(w.x & 0xffff0000u), __uint_as_float(w.y << 16), __uint_as_float(w.y & 0xffff0000u)} * is[bj][0];
                    acc[ai][bj][m][1] = (f32x4){__uint_as_float(w.z << 16), __uint_as_float(w.z & 0xffff0000u), __uint_as_float(w.w << 16), __uint_as_float(w.w & 0xffff0000u)} * is[bj][1]; }
    }
    __device__ __forceinline__ void operator()(const f32x4 (&acc)[2][2][4][2], const Unit& u, int wr, int wc, int fr, int fq, int par) const {
        const int row0 = u.pm * BM + wr * 64 + fr, col0 = u.pn * BM + wc * 64 + 8 * fq;
        f32x4 sc[2][2];
#pragma unroll
        for (int bj = 0; bj < 2; ++bj)
#pragma unroll
            for (int n = 0; n < 2; ++n) sc[bj][n] = cscale ? *(const f32x4*)(cscale + col0 + bj * 32 + 4 * n) : (f32x4){1.f, 1.f, 1.f, 1.f};
#pragma unroll
        for (int ai = 0; ai < 2; ++ai)
#pragma unroll
            for (int m = 0; m < 4; ++m) { const size_t off = (size_t)(row0 + ai * HALF + m * 16) * 1024 + col0; float qq = 0.f;
#pragma unroll
                for (int bj = 0; bj < 2; ++bj) { const f32x4 o0 = acc[ai][bj][m][0] * sc[bj][0], o1 = acc[ai][bj][m][1] * sc[bj][1];
                    *(u32x4*)(xb + off + bj * 32) = pack8(o0, o1);
                    qq += ((o0[0] * o0[0] + o0[1] * o0[1]) + (o0[2] * o0[2] + o0[3] * o0[3])) + ((o1[0] * o1[0] + o1[1] * o1[1]) + (o1[2] * o1[2] + o1[3] * o1[3])); }
                qq += __shfl_xor(qq, 16); qq += __shfl_xor(qq, 32);
                if (fq == 0) ssout[(size_t)(row0 + ai * HALF + m * 16) * 16 + u.pn * 4 + wc] = qq; }
    }
};

struct EpiQKV {
    static constexpr bool PERM = true;
    bf16_t* QKV; size_t tstride; const float* ss; const float* rope; float* kmean; PG8_LAS float* tab;
    PG8_RSTD_HOOKS
    __device__ __forceinline__ void operator()(const f32x4 (&acc)[2][2][4][2], const Unit& u, int wr, int wc, int fr, int fq, int par) const {
        const int t = u.pn >> 2;
        bf16_t* base = QKV + (size_t)t * tstride;
        const int b = u.pm >> 4, blk = u.pm & 15;
        const int cih = wc * 32 + 8 * fq;
        const int row0 = u.pm * BM + wr * 64 + fr;
        float rsv[2][4]; rstd_read(tab, par, wr, fr, rsv);
        f32x4 cs[2][2];
#pragma unroll
        for (int bj = 0; bj < 2; ++bj)
#pragma unroll
            for (int n = 0; n < 2; ++n) cs[bj][n] = (f32x4){0.f, 0.f, 0.f, 0.f};
        const bool rot = (t < 2 && wc == 0);
#pragma unroll
        for (int ap = 0; ap < 4; ++ap) {
            const int ai = ap >> 1, mp = ap & 1;
            f32x4 c[2][2], sn[2][2];
            if (rot) {
#pragma unroll
                for (int mm = 0; mm < 2; ++mm) { const float* cp = rope + (size_t)(row0 + ai * HALF + (2 * mp + mm) * 16) * 32 + 8 * (fq & 1);
                    c[mm][0] = *(const f32x4*)(cp); c[mm][1] = *(const f32x4*)(cp + 4); sn[mm][0] = *(const f32x4*)(cp + 16); sn[mm][1] = *(const f32x4*)(cp + 20); }
            }
#pragma unroll
            for (int mm = 0; mm < 2; ++mm) { const int m = 2 * mp + mm;
                const int row = row0 + ai * HALF + m * 16; const int s = row & 4095; const float rs = rsv[ai][m];
                f32x4 v[2][2];
#pragma unroll
                for (int bj = 0; bj < 2; ++bj)
#pragma unroll
                    for (int n = 0; n < 2; ++n) v[bj][n] = acc[ai][bj][m][n] * rs;
                if (rot) {
                    const float sgn = (fq < 2) ? -1.f : 1.f;
#pragma unroll
                    for (int bj = 0; bj < 2; ++bj)
#pragma unroll
                        for (int n = 0; n < 2; ++n)
#pragma unroll
                            for (int j = 0; j < 4; ++j) { const float mine = v[bj][n][j]; const float other = __shfl_xor(mine, 32); v[bj][n][j] = mine * c[mm][n][j] + sgn * other * sn[mm][n][j]; }
                }
#pragma unroll
                for (int bj = 0; bj < 2; ++bj) {
                    const int h = 2 * (u.pn & 3) + bj;
                    bf16_t* dst = base + ((size_t)((b * 8 + h) * 4096 + s)) * 128 + cih;
                    *(u32x4*)dst = pack8(v[bj][0], v[bj][1]);
                    cs[bj][0] += v[bj][0]; cs[bj][1] += v[bj][1];
                }
            }
        }
        if (t == 1) {
#pragma unroll
            for (int bj = 0; bj < 2; ++bj)
#pragma unroll
                for (int n = 0; n < 2; ++n)
#pragma unroll
                    for (int j = 0; j < 4; ++j) { float x = cs[bj][n][j]; x += __shfl_xor(x, 1); x += __shfl_xor(x, 2); x += __shfl_xor(x, 4); x += __shfl_xor(x, 8);
                        if (fr == 0) { const int h = 2 * (u.pn & 3) + bj; atomicAdd(kmean + ((size_t)((b * 8 + h) * 16 + blk)) * 128 + cih + 4 * n + j, x); } }
        }
    }
};

struct EpiConvIn {
    static constexpr bool PERM = true;
    bf16_t* Z; bf16_t* GB; const float* ss; PG8_LAS float* tab;
    PG8_RSTD_HOOKS
    __device__ __forceinline__ void operator()(const f32x4 (&acc)[2][2][4][2], const Unit& u, int wr, int wc, int fr, int fq, int par) const {
        const int row0 = u.pm * BM + wr * 64 + fr;
        float rsv[2][4]; rstd_read(tab, par, wr, fr, rsv);
#pragma unroll
        for (int ai = 0; ai < 2; ++ai)
#pragma unroll
            for (int m = 0; m < 4; ++m) { const int row = row0 + ai * HALF + m * 16; const float rs = rsv[ai][m];
                if (u.pn < 8) { const float rs2 = rs * rs;
                    const f32x4 z0 = acc[ai][0][m][0] * acc[ai][1][m][0] * rs2, z1 = acc[ai][0][m][1] * acc[ai][1][m][1] * rs2;
                    *(u32x4*)(Z + (size_t)row * 1024 + u.pn * 128 + wc * 32 + 8 * fq) = pack8(z0, z1);
                } else {
#pragma unroll
                    for (int bj = 0; bj < 2; ++bj)
                        *(u32x4*)(GB + (size_t)row * 1024 + (u.pn - 8) * 256 + bj * HALF + wc * 32 + 8 * fq) = pack8(acc[ai][bj][m][0] * rs, acc[ai][bj][m][1] * rs);
                } }
    }
};

template <class Epi>
__device__ __forceinline__ void gemm_phase(PG8_LAS unsigned char* lds, const Gemm g, const StaticOrder& S, const Epi& E) {
    const int tid = opaque_tid(), wid = __builtin_amdgcn_readfirstlane(tid >> 6), lane = tid & 63, wr = wid >> 2, wc = wid & 3, fr = lane & 15, fq = lane >> 4;
    const int K = g.K, nt = K / BK;
    const bool tA = (g.tiled & 1) != 0, tB = (g.tiled & 2) != 0;
    unsigned voffA[2], voffB[2];
#pragma unroll
    for (int i = 0; i < 2; ++i) { int R, C; stage_rc(tid * 16 + i * 8192, R, C); const int Rb = Epi::PERM ? ((R & ~31) + perm32(R & 31)) : R;
        voffA[i] = (unsigned)(R * (tA ? BK : g.lda) + C) * 2u; voffB[i] = (unsigned)(Rb * (tB ? BK : g.ldb) + C) * 2u; }
    const size_t kstepA = tA ? (size_t)(BM * BK * 2) : (size_t)(BK * 2), kstepB = tB ? (size_t)(BM * BK * 2) : (size_t)(BK * 2);
    const size_t hstepA = (size_t)HALF * (tA ? BK : g.lda) * 2, hstepB = (size_t)HALF * (tB ? BK : g.ldb) * 2;
    const size_t tstepA = tA ? (size_t)nt * (BM * BK * 2) : 2 * hstepA, tstepB = tB ? (size_t)nt * (BM * BK * 2) : 2 * hstepB;
    const unsigned ldsw = (unsigned)wid * 1024u;
    const int aoff = lds_byte(wr * 64 + fr, fq * 8), boff = lds_byte(wc * 32 + fr, fq * 8);
#define PG8_SA(b, h) (((b) * 2 + (h)) * HTB)
#define PG8_SB(b, h) ((4 + (b) * 2 + (h)) * HTB)
#define PG8_STAGE(bufoff, gbase, voff) do { _Pragma("unroll") for (int _i = 0; _i < 2; ++_i) \
        __builtin_amdgcn_global_load_lds((const unsigned*)((const char*)(gbase) + (voff)[_i]), (PG8_LAS unsigned*)(lds + (bufoff) + ldsw + _i * 8192), 16, 0, 0); } while (0)
#define PG8_LDA(dst, b, h) do { _Pragma("unroll") for (int m = 0; m < 4; ++m) _Pragma("unroll") for (int k = 0; k < 2; ++k) dst[m][k] = *(const PG8_LAS bf16x8*)(lds + PG8_SA(b, h) + aoff + m * 2048 + k * 1024); } while (0)
#define PG8_LDB(dst, b, h) do { _Pragma("unroll") for (int n = 0; n < 2; ++n) _Pragma("unroll") for (int k = 0; k < 2; ++k) dst[n][k] = *(const PG8_LAS bf16x8*)(lds + PG8_SB(b, h) + boff + n * 2048 + k * 1024); } while (0)
#define PG8_MMA(ai, bj, At, Bt) do { __builtin_amdgcn_s_setprio(1); _Pragma("unroll") for (int m = 0; m < 4; ++m) _Pragma("unroll") for (int n = 0; n < 2; ++n) _Pragma("unroll") for (int k = 0; k < 2; ++k) \
        acc[ai][bj][m][n] = __builtin_amdgcn_mfma_f32_16x16x32_bf16(Bt[n][k], At[m][k], acc[ai][bj][m][n], 0, 0, 0); __builtin_amdgcn_s_setprio(0); } while (0)
#define PG8_WAIT_V(n) asm volatile("s_waitcnt vmcnt(" #n ")" ::: "memory")
#define PG8_WAIT_L(n) asm volatile("s_waitcnt lgkmcnt(" #n ")" ::: "memory")
#define PG8_BAR __builtin_amdgcn_s_barrier()
#define PG8_SCHED __builtin_amdgcn_sched_barrier(0)
    Unit cur, nxt; int ui = 0;
    if (!S.next(0, cur)) return;
    f32x4 acc[2][2][4][2];
    typename Epi::Ini ini;
    E.init_load(acc, ini, cur, wr, wc, fr, fq);
    bf16x8 At[4][2], B0[2][2], B1[2][2];
    const char* cA = (const char*)g.A + (size_t)cur.pm * tstepA + (size_t)cur.pn * g.a_pn * 2; const char* cB = (const char*)g.Bt + (size_t)cur.pn * tstepB;
    PG8_STAGE(PG8_SB(0, 0), cB, voffB); PG8_STAGE(PG8_SB(0, 1), cB + hstepB, voffB); PG8_STAGE(PG8_SA(0, 0), cA, voffA); PG8_STAGE(PG8_SA(0, 1), cA + hstepA, voffA);
    if (wr == 1) PG8_BAR;
    PG8_WAIT_V(2); PG8_BAR;
    PG8_STAGE(PG8_SB(1, 0), cB + kstepB, voffB); PG8_STAGE(PG8_SA(1, 0), cA + kstepA, voffA); PG8_STAGE(PG8_SB(1, 1), cB + hstepB + kstepB, voffB);
    PG8_WAIT_V(6); PG8_BAR;
    E.init_apply(acc, ini, cur, wr, wc, fr, fq, 0);
    for (;;) {
        const bool has_next = S.next(ui + 1, nxt);
        const char* nA = has_next ? (const char*)g.A + (size_t)nxt.pm * tstepA + (size_t)nxt.pn * g.a_pn * 2 : cA; const char* nB = has_next ? (const char*)g.Bt + (size_t)nxt.pn * tstepB : cB;
        for (int t = 0; t < nt; t += 2) {
            const bool last = (t == nt - 2);
            const char* a1 = cA + (size_t)(t + 1) * kstepA;
            const char* a2 = last ? nA : cA + (size_t)(t + 2) * kstepA; const char* b2 = last ? nB : cB + (size_t)(t + 2) * kstepB;
            const char* a3 = a2 + kstepA; const char* b3 = b2 + kstepB;
            PG8_LDB(B0, 0, 0); PG8_LDB(B1, 0, 1); PG8_SCHED; PG8_LDA(At, 0, 0); PG8_STAGE(PG8_SA(1, 1), a1 + hstepA, voffA);
            PG8_WAIT_V(8); PG8_WAIT_L(0); PG8_BAR; PG8_MMA(0, 0, At, B0); PG8_MMA(0, 1, At, B1); PG8_BAR; PG8_SCHED;
            PG8_LDA(At, 0, 1); PG8_STAGE(PG8_SB(0, 0), b2, voffB); PG8_STAGE(PG8_SB(0, 1), b2 + hstepB, voffB); PG8_STAGE(PG8_SA(0, 0), a2, voffA);
            PG8_WAIT_V(8); PG8_WAIT_L(0); PG8_BAR; PG8_MMA(1, 0, At, B0); PG8_MMA(1, 1, At, B1); PG8_BAR; PG8_SCHED;
            PG8_LDB(B0, 1, 0); PG8_LDB(B1, 1, 1); PG8_SCHED; PG8_LDA(At, 1, 0); PG8_STAGE(PG8_SA(0, 1), a2 + hstepA, voffA);
            PG8_WAIT_V(8); PG8_WAIT_L(0); PG8_BAR; PG8_MMA(0, 0, At, B0); PG8_MMA(0, 1, At, B1); PG8_BAR; PG8_SCHED;
            PG8_LDA(At, 1, 1); PG8_STAGE(PG8_SB(1, 0), b3, voffB); PG8_STAGE(PG8_SB(1, 1), b3 + hstepB, voffB); PG8_STAGE(PG8_SA(1, 0), a3, voffA);
            PG8_WAIT_V(8); PG8_WAIT_L(0); PG8_BAR; PG8_MMA(1, 0, At, B0); PG8_MMA(1, 1, At, B1); PG8_BAR; PG8_SCHED;
        }
        if (wr == 0) PG8_BAR;
        if (has_next) E.next_load(ini, nxt);
        E(acc, cur, wr, wc, fr, fq, ui & 1);
        if (!has_next) break;
        cur = nxt; cA = nA; cB = nB; ++ui;
        E.next_apply(acc, ini, cur, wr, wc, fr, fq, ui & 1);
        if (wr == 1) PG8_BAR;
    }
    PG8_WAIT_V(0);
    PG8_BAR;
#undef PG8_SA
#undef PG8_SB
#undef PG8_STAGE
#undef PG8_LDA
#undef PG8_LDB
#undef PG8_MMA
#undef PG8_WAIT_V
#undef PG8_WAIT_L
#undef PG8_BAR
#undef PG8_SCHED
}
}

namespace att {
typedef unsigned short bf16;
typedef short bf16x8 __attribute__((ext_vector_type(8)));
typedef short s16x4 __attribute__((ext_vector_type(4)));
typedef float f32x16 __attribute__((ext_vector_type(16)));
typedef float f32x4 __attribute__((ext_vector_type(4)));
typedef unsigned u32x4 __attribute__((ext_vector_type(4)));
constexpr int D = 128, OSTR = 1024;
constexpr float SCALE = 0.08838834764831845f;
constexpr float THR = 8.f;
constexpr int NW = 8, QBLK = 32, KVBLK = 64, QB = NW * QBLK;
constexpr int SHM_V = KVBLK * D * 2, SHM_K = KVBLK * D * 2;
constexpr int LDS_BYTES = 2 * SHM_V + 2 * SHM_K + NW * 64 * 4;

#define KSWZ(row, colB) ((row) * 256 + ((colB) ^ (((row) & 7) << 4)))
#define SBAR() __builtin_amdgcn_sched_barrier(0)
__device__ __forceinline__ int v_st(int k, int c) { const int kk = (k & ~0xC) | ((k & 4) << 1) | ((k & 8) >> 1); return ((kk >> 3) * 4 + (c >> 5)) * 512 + ((kk & 7) * 32 + (c & 31)) * 2; }
__device__ __forceinline__ int v_rd_base(int lane) { return ((lane & 3) << 3) | (((lane >> 2) & 3) << 6) | (((lane >> 4) & 1) << 5) | (((lane >> 5) & 1) << 8); }
constexpr int v_rd_off(int d0, int ks, int half) { return d0 * 512 + ks * 4096 + half * 2048; }
__device__ __forceinline__ int crow(int r, int hi) { return (r & 3) + 8 * (r >> 2) + 4 * hi; }
__device__ __forceinline__ unsigned cvtpk(float lo, float hi) { unsigned r; asm volatile("v_cvt_pk_bf16_f32 %0, %1, %2" : "=v"(r) : "v"(lo), "v"(hi)); return r; }
__device__ __forceinline__ bf16x8 pack8(f32x4 a, f32x4 b) { u32x4 w = {cvtpk(a[0], a[1]), cvtpk(a[2], a[3]), cvtpk(b[0], b[1]), cvtpk(b[2], b[3])}; return *reinterpret_cast<bf16x8*>(&w); }
__device__ __forceinline__ bf16x8 load8(const bf16* p) { return *reinterpret_cast<const bf16x8*>(p); }

__device__ __forceinline__ void mask_tile(f32x16& p0, f32x16& p1, int dq, unsigned W) {
    const float NEG = -__builtin_inff();
#pragma unroll
    for (int r = 0; r < 16; ++r) {
        const int c = (r & 3) + 8 * (r >> 2);
        if ((unsigned)(dq - c) >= W) p0[r] = NEG;
        if ((unsigned)(dq - c - 32) >= W) p1[r] = NEG;
    }
}
__device__ __forceinline__ void partialSM(f32x16& p0, f32x16& p1, float& m_reg, float& mn, float& alpha, bool rs) {
    float pmax = p0[0]; for (int r = 1; r < 16; ++r) pmax = fmaxf(pmax, p0[r]); for (int r = 0; r < 16; ++r) pmax = fmaxf(pmax, p1[r]);
    if (!rs) pmax = -__builtin_inff();
    { auto rr = __builtin_amdgcn_permlane32_swap(__float_as_uint(pmax), __float_as_uint(pmax), false, false);
      pmax = fmaxf(__uint_as_float(rr[0]), __uint_as_float(rr[1])); }
    constexpr float C2 = 1.4426950408889634f * SCALE;
    if (__builtin_expect(__all((pmax - m_reg) * SCALE <= THR), 1)) { mn = m_reg; alpha = 1.f; }
    else { mn = fmaxf(m_reg, pmax); alpha = __builtin_amdgcn_exp2f((m_reg - mn) * C2); m_reg = mn; }
    const float mnL = rs ? -mn * C2 : -__builtin_inff();
    for (int r = 0; r < 16; ++r) p0[r] = fmaf(p0[r], C2, mnL); for (int r = 0; r < 16; ++r) p1[r] = fmaf(p1[r], C2, mnL);
    for (int r = 0; r < 16; ++r) p0[r] = __builtin_amdgcn_exp2f(p0[r]);
}
__device__ __forceinline__ void finishSM(f32x16& p0, f32x16& p1, float alpha, float& l_reg, bf16x8& pa0, bf16x8& pa1, bf16x8& pa2, bf16x8& pa3) {
    for (int r = 0; r < 16; ++r) p1[r] = __builtin_amdgcn_exp2f(p1[r]);
    float ps = 0; for (int r = 0; r < 16; ++r) ps += p0[r]; for (int r = 0; r < 16; ++r) ps += p1[r];
    { auto rr = __builtin_amdgcn_permlane32_swap(__float_as_uint(ps), __float_as_uint(ps), false, false);
      ps = __uint_as_float(rr[0]) + __uint_as_float(rr[1]); }
    l_reg = l_reg * alpha + ps;
#define PK4(P, B_, OUT) do { unsigned a0 = cvtpk(P[B_+0], P[B_+1]), a1 = cvtpk(P[B_+2], P[B_+3]);                          \
        unsigned b0 = cvtpk(P[B_+4], P[B_+5]), b1 = cvtpk(P[B_+6], P[B_+7]);                                             \
        auto r0 = __builtin_amdgcn_permlane32_swap(a0, b0, false, false); auto r1 = __builtin_amdgcn_permlane32_swap(a1, b1, false, false); \
        u32x4 w = {r0[0], r1[0], r0[1], r1[1]}; OUT = *reinterpret_cast<bf16x8*>(&w); } while (0)
    PK4(p0, 0, pa0); PK4(p0, 8, pa1); PK4(p1, 0, pa2); PK4(p1, 8, pa3);
#undef PK4
}
template <int KB>
__device__ __forceinline__ void qkt(f32x16& p0, f32x16& p1, const char* K_lds, int r32, int hi, const bf16x8* qr) {
    p0 = f32x16{}; p1 = f32x16{};
    const char* kb[4];
#pragma unroll
    for (int dd = 0; dd < 4; ++dd) kb[dd] = K_lds + KB * SHM_K + KSWZ(r32, (dd * 16 + hi * 8) * 2);
#pragma unroll
    for (int d0 = 0; d0 < 8; ++d0) { const char* a = kb[d0 & 3] + (d0 >> 2) * 128;
        bf16x8 b0 = *reinterpret_cast<const bf16x8*>(a);
        bf16x8 b1 = *reinterpret_cast<const bf16x8*>(a + 32 * 256);
        p0 = __builtin_amdgcn_mfma_f32_32x32x16_bf16(b0, qr[d0], p0, 0, 0, 0);
        p1 = __builtin_amdgcn_mfma_f32_32x32x16_bf16(b1, qr[d0], p1, 0, 0, 0); }
}
template <int VB>
__device__ __forceinline__ void pv_tile(f32x16* o, int vb0, bf16x8 pa0, bf16x8 pa1, bf16x8 pa2, bf16x8 pa3) {
#define TRRD(dst, off) asm volatile("ds_read_b64_tr_b16 %0, %1 offset:%2" : "=&v"(dst) : "v"(vb0), "i"(off) : "memory")
#define PV_D0(d0) do { s16x4 l0, l1, l2, l3, h0, h1, h2, h3; constexpr int b_ = VB * SHM_V + v_rd_off(d0, 0, 0); \
        TRRD(l0, b_); TRRD(h0, b_ + 2048); TRRD(l1, b_ + 4096); TRRD(h1, b_ + 6144); TRRD(l2, b_ + 8192); TRRD(h2, b_ + 10240); TRRD(l3, b_ + 12288); TRRD(h3, b_ + 14336); \
        asm volatile("s_waitcnt lgkmcnt(0)" ::: "memory"); SBAR();   \
        o[d0] = __builtin_amdgcn_mfma_f32_32x32x16_bf16(pa0, (bf16x8){l0[0], l0[1], l0[2], l0[3], h0[0], h0[1], h0[2], h0[3]}, o[d0], 0, 0, 0);   \
        o[d0] = __builtin_amdgcn_mfma_f32_32x32x16_bf16(pa1, (bf16x8){l1[0], l1[1], l1[2], l1[3], h1[0], h1[1], h1[2], h1[3]}, o[d0], 0, 0, 0);   \
        o[d0] = __builtin_amdgcn_mfma_f32_32x32x16_bf16(pa2, (bf16x8){l2[0], l2[1], l2[2], l2[3], h2[0], h2[1], h2[2], h2[3]}, o[d0], 0, 0, 0);   \
        o[d0] = __builtin_amdgcn_mfma_f32_32x32x16_bf16(pa3, (bf16x8){l3[0], l3[1], l3[2], l3[3], h3[0], h3[1], h3[2], h3[3]}, o[d0], 0, 0, 0); } while (0)
    PV_D0(0); PV_D0(1); PV_D0(2); PV_D0(3);
#undef PV_D0
#undef TRRD
}

struct BlockRef { const bf16* Q; const bf16* K; const bf16* V; bf16* O; const float* km; int P0; int qb; };
struct Seam { bf16x8 qr[8]; bf16x8 st_v0, st_v1, st_k0, st_k1; };

constexpr int KM_LDS_OFF = 69632, KM_PITCH = 272;
__device__ __forceinline__ void stage_kmean(char* lds, const float* km) {
    const int tid = opaque_tid(), row = tid >> 4, chunk = tid & 15;
    const float* kp = km + (row & 15) * 128 + chunk * 8;
    f32x4 a = *(const f32x4*)kp, b = *(const f32x4*)(kp + 4);
    a = a * (1.0f / 256.0f); b = b * (1.0f / 256.0f);
    const bf16x8 h = pack8(a, b);
    f32x4 ah, bh;
#pragma unroll
    for (int j = 0; j < 4; ++j) { ah[j] = __uint_as_float(((unsigned)(unsigned short)h[j]) << 16); bh[j] = __uint_as_float(((unsigned)(unsigned short)h[4 + j]) << 16); }
    const bf16x8 l = pack8(a - ah, b - bh);
    *(bf16x8*)(lds + KM_LDS_OFF + row * KM_PITCH + chunk * 16) = (row >= 16) ? l : h;
}
__device__ __forceinline__ unsigned gate_select(const bf16x8* qr, const char* lds, int qb, int r32, int hi) {
    if (qb <= 3) return (1u << qb) - 1u;
    f32x16 p = {};
    const char* kp = lds + KM_LDS_OFF + r32 * KM_PITCH + hi * 16;
#pragma unroll
    for (int d0 = 0; d0 < 8; ++d0) {
        const bf16x8 frag = *(const bf16x8*)(kp + d0 * 32);
        p = __builtin_amdgcn_mfma_f32_32x32x16_bf16(frag, qr[d0], p, 0, 0, 0);
    }
    float g[16];
#pragma unroll
    for (int r = 0; r < 8; ++r) { const float v = p[r] + p[r + 8];
        auto rr = __builtin_amdgcn_permlane32_swap(__float_as_uint(v), __float_as_uint(v), false, false);
        g[(r & 3) + 8 * (r >> 2)] = __uint_as_float(rr[0]); g[(r & 3) + 8 * (r >> 2) + 4] = __uint_as_float(rr[1]); }
    unsigned sel = 0u;
#pragma unroll
    for (int pass = 0; pass < 3; ++pass) { float best = -__builtin_inff(); int bi = -1;
#pragma unroll
        for (int n = 0; n < 16; ++n) { const bool ok = (n < qb) && !((sel >> n) & 1u) && (g[n] > best); best = ok ? g[n] : best; bi = ok ? n : bi; }
        if (bi >= 0) sel |= 1u << bi; }
    return sel;
}

#define ROW(p, k0, rr) ((p) + (size_t)((k0) + (rr)) * D + sc)
#define VMW() asm volatile("s_waitcnt vmcnt(0)" ::: "memory")
#define VMWN(n) asm volatile("s_waitcnt vmcnt(%0)" :: "i"(n) : "memory")
#define SLOAD_H(Kp, Vp, k0) do { S.st_v0 = load8(ROW(Vp, k0, sr)); S.st_v1 = load8(ROW(Vp, k0, 32 + sr));              \
                         S.st_k0 = load8(ROW(Kp, k0, sr)); S.st_k1 = load8(ROW(Kp, k0, 32 + sr)); } while (0)
#define SWRITE_HK(bf) do { *(bf16x8*)(K_lds + (bf) * SHM_K + kws) = S.st_k0; *(bf16x8*)(K_lds + (bf) * SHM_K + kws + 32 * 256) = S.st_k1; } while (0)
#define SWRITE_HV(bf) do { *(bf16x8*)(V_lds + (bf) * SHM_V + vst0) = S.st_v0; *(bf16x8*)(V_lds + (bf) * SHM_V + vst1) = S.st_v1; } while (0)
#define SWRITE_H(bf) do { SWRITE_HV(bf); SWRITE_HK(bf); } while (0)

__device__ __forceinline__ void moba_prime(const BlockRef& cur, char* lds, Seam& S) {
    const int tid = opaque_tid(), wid = __builtin_amdgcn_readfirstlane(tid >> 6), lane = tid & 63, r32 = lane & 31, hi = lane >> 5;
    const int sr = tid >> 4, sc = (tid & 15) * 8, kws = KSWZ(sr, sc * 2); char* K_lds = lds + 2 * SHM_V;
    for (int d0 = 0; d0 < 8; ++d0) S.qr[d0] = load8(cur.Q + (size_t)(wid * QBLK + r32) * D + d0 * 16 + hi * 8);
    SLOAD_H(cur.K, cur.V, 0); VMW(); SWRITE_HK(0);
    __syncthreads();
}
__device__ __forceinline__ void moba_block(const BlockRef& cur, const BlockRef& nxt, char* lds, Seam& S) {
    const int tid = opaque_tid(), wid = __builtin_amdgcn_readfirstlane(tid >> 6), lane = tid & 63, r32 = lane & 31, hi = lane >> 5;
    const int NT = (cur.qb + 1) * 4;
    constexpr int W = 0x40000000;
    const int qlo = cur.P0 + wid * QBLK, qm = qlo + r32 - 4 * hi;
    char* V_lds = lds; char* K_lds = lds + 2 * SHM_V;
    float* ws = (float*)(lds + 2 * SHM_V + 2 * SHM_K) + wid * 64; float* li_l = ws, * al_l = ws + 32;
    float m_reg = -1e30f, l_reg = 0; f32x16 o[4] = {};
    const int sr = tid >> 4, sc = (tid & 15) * 8, vst0 = v_st(sr, sc), vst1 = v_st(32 + sr, sc), kws = KSWZ(sr, sc * 2);
    const int vb0 = (int)(uintptr_t)V_lds + v_rd_base(lane);
    const bf16* Kh = cur.K; const bf16* Vh = cur.V;
    const int qb = cur.qb;
    const unsigned sel = gate_select(S.qr, lds, qb, r32, hi);
#define RSEL(t) ((((t) >> 2) >= qb) || (((sel >> ((t) >> 2)) & 1u) != 0u))
#define RESC(a) do { if (__any((a) < 1.f)) { if (hi == 0) al_l[r32] = (a); asm volatile("s_waitcnt lgkmcnt(0)" ::: "memory");              \
                     for (int d_ = 0; d_ < 4; ++d_) for (int r = 0; r < 16; ++r) o[d_][r] *= al_l[crow(r, hi)]; } } while (0)
#define KBASE(t) ((t) * KVBLK)
#define MASKT(P0_, P1_, t) do { const int kb_ = KBASE(t); if (kb_ + KVBLK - 1 > qlo) mask_tile(P0_, P1_, qm - kb_, (unsigned)W); } while (0)
    constexpr int NQL = 8;
#define SEAM_K0() do { VMWN(NQL); SWRITE_HK(0); SBAR(); } while (0)
    f32x16 pA0, pA1, pB0, pB1; float mnA, mnB, alA, alB; bf16x8 pa0, pa1, pa2, pa3;
    SWRITE_HV(0); SBAR();
    if (NT > 1) { SLOAD_H(Kh, Vh, KBASE(1)); }
    SBAR(); qkt<0>(pA0, pA1, K_lds, r32, hi, S.qr);
    MASKT(pA0, pA1, 0); partialSM(pA0, pA1, m_reg, mnA, alA, RSEL(0));
    if (NT > 1) { VMW(); SWRITE_H(1); }
    __syncthreads();
#define HALF_STEP(PX0, PX1, mnX, alX, PY0, PY1, alY, t, KB, VB, SB) do {                                                      \
        SBAR(); qkt<KB>(PX0, PX1, K_lds, r32, hi, S.qr);                                                                      \
        finishSM(PY0, PY1, alY, l_reg, pa0, pa1, pa2, pa3); SBAR();                                                           \
        if ((t) + 1 < NT) { SLOAD_H(Kh, Vh, KBASE((t) + 1)); SBAR(); }                                                        \
        pv_tile<VB>(o, vb0, pa0, pa1, pa2, pa3); MASKT(PX0, PX1, (t)); partialSM(PX0, PX1, m_reg, mnX, alX, RSEL(t));         \
        __syncthreads();                                                                                                      \
        if ((t) + 1 < NT) { VMW(); SWRITE_H(SB); }                                                                            \
        RESC(alX); __syncthreads(); } while (0)
    for (int t = 1; t + 1 < NT; t += 2) {
        HALF_STEP(pB0, pB1, mnB, alB, pA0, pA1, alA, t, 1, 0, 0);
        HALF_STEP(pA0, pA1, mnA, alA, pB0, pB1, alB, t + 1, 0, 1, 1);
    }
    const bool even = (NT & 1) == 0;
    if (even) { SBAR(); qkt<1>(pB0, pB1, K_lds, r32, hi, S.qr); SBAR(); }
    SLOAD_H(nxt.K, nxt.V, 0); SBAR();
#pragma unroll
    for (int d0 = 0; d0 < 8; ++d0) S.qr[d0] = load8(nxt.Q + (size_t)(wid * QBLK + r32) * D + d0 * 16 + hi * 8);
    SBAR();
    finishSM(pA0, pA1, alA, l_reg, pa0, pa1, pa2, pa3); SBAR();
    pv_tile<0>(o, vb0, pa0, pa1, pa2, pa3);
    if (even) { MASKT(pB0, pB1, NT - 1); partialSM(pB0, pB1, m_reg, mnB, alB, RSEL(NT - 1)); __syncthreads(); RESC(alB);
        finishSM(pB0, pB1, alB, l_reg, pa0, pa1, pa2, pa3); SBAR(); pv_tile<1>(o, vb0, pa0, pa1, pa2, pa3); }
    SBAR(); SEAM_K0();
    if (hi == 0) li_l[r32] = l_reg; asm volatile("s_waitcnt lgkmcnt(0)" ::: "memory");
    float rli[16];
#pragma unroll
    for (int r = 0; r < 16; ++r) rli[r] = __builtin_amdgcn_rcpf(li_l[crow(r, hi)]);
    bf16* Ow = cur.O + (size_t)(wid * QBLK) * OSTR;
#pragma unroll
    for (int r = 0; r < 16; ++r) { const int orow = crow(r, hi);
#pragma unroll
        for (int d0 = 0; d0 < 4; ++d0) { const float v = o[d0][r] * rli[r];
            const float vn = __shfl_xor(v, 1);
            if ((r32 & 1) == 0) *(unsigned*)(Ow + (size_t)orow * OSTR + d0 * 32 + r32) = cvtpk(v, vn); } }
    __syncthreads();
#undef RSEL
#undef RESC
#undef KBASE
#undef MASKT
#undef SEAM_K0
#undef HALF_STEP
}
#undef ROW
#undef VMW
#undef VMWN
#undef SLOAD_H
#undef SWRITE_HK
#undef SWRITE_HV
#undef SWRITE_H

__device__ __forceinline__ BlockRef moba_ref(int L, int pass, const bf16* Q, const bf16* K, const bf16* V, bf16* O, const float* kmean) {
    const int bh = L >> 3, x = L & 7, qb = pass ? 15 - x : x, b = bh >> 3, h = bh & 7;
    BlockRef r;
    r.Q = Q + ((size_t)bh * 4096 + (size_t)qb * QB) * D; r.K = K + (size_t)bh * 4096 * D; r.V = V + (size_t)bh * 4096 * D;
    r.O = O + ((size_t)b * 4096 + (size_t)qb * QB) * OSTR + h * D; r.km = kmean + (size_t)bh * 16 * 128; r.P0 = qb * QB; r.qb = qb;
    return r;
}
__device__ __forceinline__ void moba_phase(char* lds, const bf16* Q, const bf16* K, const bf16* V, bf16* O, const float* kmean, int vcu, int G) {
    constexpr int total = 256;
    int L = vcu; if (L >= total) return;
    int pass = 0;
    BlockRef cur = moba_ref(L, 0, Q, K, V, O, kmean);
    Seam S;
    stage_kmean(lds, cur.km);
    moba_prime(cur, lds, S);
    for (;;) {
        const bool more_pass = pass == 0, more_item = L + G < total, last = !more_pass && !more_item;
        int passn = pass + 1, Ln = L;
        if (!more_pass) { passn = 0; Ln = more_item ? L + G : L; }
        const BlockRef nxt = last ? cur : moba_ref(Ln, passn, Q, K, V, O, kmean);
        moba_block(cur, nxt, lds, S);
        if (last) break;
        if (passn == 0) { stage_kmean(lds, nxt.km); __syncthreads(); }
        cur = nxt; pass = passn; L = Ln;
    }
}
#undef SBAR
}

constexpr int NWAVES = 8;
constexpr int M = 16384, DM = 1024, SEQ = 4096, FF = 4096;
constexpr size_t MiB = 1u << 20;
constexpr size_t WS_SS = 1 * MiB, WS_ROPE = 3 * MiB, WS_KM = 5 * MiB;
constexpr size_t WS_WQKV = 6 * MiB, WS_WO = 18 * MiB, WS_WPOOL = 22 * MiB, WS_WCI = 23 * MiB, WS_WCO = 29 * MiB, WS_WUP = 31 * MiB, WS_WDN = 63 * MiB;
constexpr size_t WS_XB = 95 * MiB, WS_ACT = 127 * MiB, WS_END = 255 * MiB;
constexpr int LDS_BYTES = 147456;
constexpr int N_PHASES = 22;

#define LAS __attribute__((address_space(3)))
typedef unsigned short bf16;
typedef unsigned v4u __attribute__((ext_vector_type(4)));
typedef unsigned v2u __attribute__((ext_vector_type(2)));
typedef float f32x4 __attribute__((ext_vector_type(4)));
#define LDS_WAIT() asm volatile("s_waitcnt lgkmcnt(0)" ::: "memory")
__device__ __forceinline__ unsigned pk2(float lo, float hi) { return pg8::cvt_pk_bf16(lo, hi); }
__device__ __forceinline__ float bf_lo(unsigned w) { return __uint_as_float(w << 16); }
__device__ __forceinline__ float bf_hi(unsigned w) { return __uint_as_float(w & 0xffff0000u); }

__device__ __forceinline__ float wave_sum(float v) {
#pragma unroll
    for (int o = 1; o < 64; o <<= 1) v += __shfl_xor(v, o);
    return v;
}
constexpr int XP_STRIDE = 65, XP_WAVE_BYTES = 64 * XP_STRIDE * 4;
__device__ __forceinline__ void xpose_item(const float* W, int K, int N, bf16* WT, const float* gain, int cmap, LAS float* scr, int item, int lane) {
    const int nblk = N / 64, kb = item / nblk, nb = item % nblk, k0 = 64 * kb, n0 = 64 * nb;
    const int n4 = (lane & 15) * 4, ks = lane >> 4;
    f32x4 w[16];
#pragma unroll
    for (int i = 0; i < 16; ++i) w[i] = __builtin_nontemporal_load((const f32x4*)(W + (size_t)(k0 + 4 * i + ks) * N + n0 + n4));
    if (gain) {
#pragma unroll
        for (int i = 0; i < 16; ++i) w[i] = w[i] * gain[k0 + 4 * i + ks];
    }
#pragma unroll
    for (int i = 0; i < 16; ++i) { LAS float* d = scr + (4 * i + ks) * XP_STRIDE + n4; d[0] = w[i][0]; d[1] = w[i][1]; d[2] = w[i][2]; d[3] = w[i][3]; }
    LDS_WAIT(); asm volatile("" ::: "memory");
    int r0 = n0;
    if (cmap == 1) { if (n0 < 1024) r0 = 2048 + n0; else if (n0 < 2048) { const int c = n0 - 1024; r0 = (c >> 7) * 256 + (c & 127); } else { const int c = n0 - 2048; r0 = (c >> 7) * 256 + 128 + (c & 127); } }
    const int c = lane & 7;
#pragma unroll
    for (int j = 0; j < 8; ++j) { const int n = (lane >> 3) + 8 * j; const LAS float* sp = scr + (8 * c) * XP_STRIDE + n;
        v4u o; o.x = pk2(sp[0 * XP_STRIDE], sp[1 * XP_STRIDE]); o.y = pk2(sp[2 * XP_STRIDE], sp[3 * XP_STRIDE]); o.z = pk2(sp[4 * XP_STRIDE], sp[5 * XP_STRIDE]); o.w = pk2(sp[6 * XP_STRIDE], sp[7 * XP_STRIDE]);
        int rr = r0 + n;
        if (cmap == 4) { const int cc = rr & 255; rr = (rr & ~255) + 128 * ((cc >> 5) & 1) + 32 * (cc >> 6) + (cc & 31); }
        *(v4u*)(WT + (size_t)rr * K + k0 + 8 * c) = o; }
    LDS_WAIT(); asm volatile("" ::: "memory");
}

#define XB_TMO      128
#define XB_XCNT(j)  (256  + 64 * (j))
#define XB_XSUB(j)  (1280 + 64 * (j))
#define XB_XGEN(j)  (2304 + 64 * (j))
#define XB_TOP      3328
#define XB_TOPGEN   3392
#define XCD_BAR_WORDS 3456
#define XB_SPIN_CAP (1u << 18)
__device__ __forceinline__ unsigned xb_ld(unsigned* p)              { return __hip_atomic_load(p, __ATOMIC_RELAXED, __HIP_MEMORY_SCOPE_AGENT); }
__device__ __forceinline__ unsigned xb_add(unsigned* p, unsigned v) { return __hip_atomic_fetch_add(p, v, __ATOMIC_RELAXED, __HIP_MEMORY_SCOPE_AGENT); }
__device__ __forceinline__ unsigned xb_xcc_id() { return (unsigned)__builtin_amdgcn_s_getreg((3 << 11) | 20) & 0xFu; }
#define XB_SPIN(cond, bar) do { unsigned _sp = 0; while (cond) { __builtin_amdgcn_s_sleep(1); \
    if ((++_sp & 255u) == 0u) { if (xb_ld(&(bar)[XB_TMO])) break; if (_sp > XB_SPIN_CAP) { atomicAdd(&(bar)[XB_TMO], 1u); break; } } } } while (0)
struct XcdBarrier { unsigned* bar; unsigned x; volatile LAS unsigned* st; };
__device__ __forceinline__ XcdBarrier xcd_barrier_post(unsigned* bar, volatile LAS unsigned* st) {
    XcdBarrier b; b.bar = bar; b.x = xb_xcc_id(); b.st = st;
    if (threadIdx.x == 0) (void)xb_add(&bar[XB_XCNT(b.x)], 1u);
    return b;
}
__device__ __forceinline__ void xcd_barrier_complete(unsigned* bar, unsigned x, unsigned& nloc, unsigned& nx) {
    const unsigned G = gridDim.x * gridDim.y * gridDim.z;
    unsigned sum, cnt, mine, sp = 0u;
    for (;;) {
        sum = 0u; cnt = 0u; mine = 0u;
#pragma unroll
        for (unsigned j = 0; j < 16; ++j) { const unsigned c = xb_ld(&bar[XB_XCNT(j)]); sum += c; cnt += (c > 0u) ? 1u : 0u; mine = (j == x) ? c : mine; }
        if (sum == G) break;
        __builtin_amdgcn_s_sleep(1);
        if ((++sp & 255u) == 0u) { if (xb_ld(&bar[XB_TMO])) break; if (sp > XB_SPIN_CAP) { atomicAdd(&bar[XB_TMO], 1u); break; } }
    }
    nloc = mine > 0u ? mine : 1u; nx = cnt > 0u ? cnt : 1u;
}
__device__ __forceinline__ void xcd_barrier(const XcdBarrier& b) {
    asm volatile("s_waitcnt vmcnt(0)" ::: "memory");
    __syncthreads();
    if (threadIdx.x == 0) {
        unsigned* bar = b.bar;
        __builtin_amdgcn_s_waitcnt(0);
        unsigned nloc = b.st[0], nx = b.st[1];
        if (nloc == 0u) { xcd_barrier_complete(bar, b.x, nloc, nx); b.st[0] = nloc; b.st[1] = nx; }
        const unsigned old = xb_add(&bar[XB_XSUB(b.x)], 1u);
        const unsigned gen = old / nloc;
        if (old + 1u == (gen + 1u) * nloc) {
            __builtin_amdgcn_fence(__ATOMIC_RELEASE, "agent");
            asm volatile("s_waitcnt vmcnt(0)" ::: "memory");
            const unsigned og = xb_add(&bar[XB_TOP], 1u);
            const unsigned tg = og / nx;
            if (og + 1u == (tg + 1u) * nx) xb_add(&bar[XB_TOPGEN], 1u);
            else XB_SPIN(xb_ld(&bar[XB_TOPGEN]) == tg, bar);
            __builtin_amdgcn_fence(__ATOMIC_ACQUIRE, "agent");
            xb_add(&bar[XB_XGEN(b.x)], 1u);
            asm volatile("s_waitcnt vmcnt(0)" ::: "memory");
        } else {
            XB_SPIN(xb_ld(&bar[XB_XGEN(b.x)]) == gen, bar);
            __builtin_amdgcn_fence(__ATOMIC_ACQUIRE, "agent");
            asm volatile("s_waitcnt vmcnt(0)" ::: "memory");
        }
    }
    __syncthreads();
}

struct Args { const float* in[14]; float* out; unsigned char* ws; int ph_lo, ph_hi; };

__device__ __forceinline__ void prologue(const Args& a, LAS unsigned char* lds, int vcu, int G, int wave, int lane, int tid) {
    unsigned char* ws = a.ws;
    LAS float* scr = (LAS float*)(lds + wave * XP_WAVE_BYTES);
    const int gw = vcu * NWAVES + wave, NGW = G * NWAVES;
    constexpr int I_QKV = 16 * 48, I_SQ = 16 * 16, I_POOL = 4 * 4, I_UP = 16 * 64, I_DN = 64 * 16;
    constexpr int NITEMS = 2 * I_QKV + 2 * I_SQ + 4 * I_POOL + I_QKV + I_SQ + 4 * I_UP + 4 * I_DN;
    const float* nmix = a.in[2]; const float* nmlp = a.in[3];
    for (int it = gw; it < NITEMS; it += NGW) {
        int r = it;
        if (r < 2 * I_QKV) { const int l = r / I_QKV; r -= l * I_QKV; xpose_item(a.in[4] + (size_t)l * 1024 * 3072, 1024, 3072, (bf16*)(ws + WS_WQKV) + (size_t)l * 3072 * 1024, nmix + (l ? 3 : 0) * 1024, 0, scr, r, lane); continue; } r -= 2 * I_QKV;
        if (r < 2 * I_SQ) { const int l = r / I_SQ; r -= l * I_SQ; xpose_item(a.in[5] + (size_t)l * 1024 * 1024, 1024, 1024, (bf16*)(ws + WS_WO) + (size_t)l * 1024 * 1024, nullptr, 4, scr, r, lane); continue; } r -= 2 * I_SQ;
        if (r < 4 * I_POOL) { const int g = r / I_POOL; r -= g * I_POOL; xpose_item(a.in[6] + (size_t)g * 65536, 256, 256, (bf16*)(ws + WS_WPOOL) + (size_t)g * 65536, nullptr, 4, scr, r, lane); continue; } r -= 4 * I_POOL;
        if (r < I_QKV) { xpose_item(a.in[8], 1024, 3072, (bf16*)(ws + WS_WCI), nmix + 2 * 1024, 1, scr, r, lane); continue; } r -= I_QKV;
        if (r < I_SQ) { xpose_item(a.in[10], 1024, 1024, (bf16*)(ws + WS_WCO), nullptr, 4, scr, r, lane); continue; } r -= I_SQ;
        if (r < 4 * I_UP) { const int l = r / I_UP; r -= l * I_UP; xpose_item(a.in[11] + (size_t)l * 1024 * 4096, 1024, 4096, (bf16*)(ws + WS_WUP) + (size_t)l * 4096 * 1024, nmlp + l * 1024, 4, scr, r, lane); continue; } r -= 4 * I_UP;
        { const int l = r / I_DN; r -= l * I_DN; xpose_item(a.in[12] + (size_t)l * 4096 * 1024, 4096, 1024, (bf16*)(ws + WS_WDN) + (size_t)l * 1024 * 4096, nullptr, 4, scr, r, lane); }
    }
    {   const float* x = a.in[0]; bf16* xb = (bf16*)(ws + WS_XB); float* ss = (float*)(ws + WS_SS);
        for (int m0 = gw; m0 < M; m0 += 2 * NGW) {
            f32x4 v[2][4]; float sq[2];
#pragma unroll
            for (int u = 0; u < 2; ++u) { const int m = m0 + u * NGW; const f32x4* xr = (const f32x4*)(x + (size_t)(m < M ? m : m0) * DM) + lane;
#pragma unroll
                for (int j = 0; j < 4; ++j) v[u][j] = __builtin_nontemporal_load(xr + 64 * j); }
#pragma unroll
            for (int u = 0; u < 2; ++u) { float s = 0.f;
#pragma unroll
                for (int j = 0; j < 4; ++j) s += (v[u][j][0] * v[u][j][0] + v[u][j][1] * v[u][j][1]) + (v[u][j][2] * v[u][j][2] + v[u][j][3] * v[u][j][3]);
                sq[u] = wave_sum(s); }
#pragma unroll
            for (int u = 0; u < 2; ++u) { const int m = m0 + u * NGW; if (m < M) {
                v2u* o8 = (v2u*)(xb + (size_t)m * DM) + lane;
#pragma unroll
                for (int j = 0; j < 4; ++j) { v2u w; w.x = pk2(v[u][j][0], v[u][j][1]); w.y = pk2(v[u][j][2], v[u][j][3]); o8[64 * j] = w; }
                if (lane < 16) ss[(size_t)m * 16 + lane] = (lane == 0) ? sq[u] : 0.f; } }
        }
    }
    {   const int gt = vcu * 512 + tid, NT = G * 512;
        const int* pos = (const int*)a.in[1]; float* rope = (float*)(ws + WS_ROPE);
        const float invf[16] = {1.0f, 0.44036659598350525f, 0.1939227432012558f, 0.08539710193872452f, 0.03760603070259094f, 0.016560440883040428f, 0.007292664609849453f, 0.0032114461064338684f,
                                0.0014142135623842478f, 0.0006227724370546639f, 0.00027424818836152554f, 0.00012076973507646471f, 5.3182957344688475e-05f, 2.34199997066753e-05f, 1.0313385246263351e-05f, 4.541670477919979e-06f};
        for (int i = gt; i < M * 16; i += NT) { const int row = i >> 4, f = i & 15;
            float fr = invf[0];
#pragma unroll
            for (int q = 1; q < 16; ++q) fr = (f == q) ? invf[q] : fr;
            const float ang = (float)pos[row] * fr;
            const double ad = (double)ang; const double k = __builtin_rint(ad * 0.15915494309189535); const float rf = (float)(ad - k * 6.283185307179586);
            rope[(size_t)row * 32 + f] = __cosf(rf); rope[(size_t)row * 32 + 16 + f] = __sinf(rf); }
        float* km = (float*)(ws + WS_KM);
        for (int i = gt; i < 2 * 65536; i += NT) km[i] = 0.f;
    }
}

__device__ __forceinline__ f32x4 ld4bf(const bf16* p) { const v2u w = *(const v2u*)p; return (f32x4){bf_lo(w.x), bf_hi(w.x), bf_lo(w.y), bf_hi(w.y)}; }
__device__ __forceinline__ void pool_prep(const bf16* X, const float* ss, const float* gain, bf16* PB, LAS unsigned char* lds, int vcu, int G, int tid) {
    LAS float* rsl = (LAS float*)lds;
    for (int chunk = vcu; chunk < M / 64; chunk += G) {
        const int r0 = chunk * 64, bstart = r0 & ~(SEQ - 1);
        __syncthreads();
        if (tid < 80) { const int row = r0 - 16 + tid; rsl[tid] = (row >= bstart) ? pg8::row_rstd(ss, row) : 0.f; }
        __syncthreads();
        const int q = tid & 255, half = tid >> 8, w = 2 << (q >> 6);
        const f32x4 gn = *(const f32x4*)(gain + 4 * q);
        const int ra = r0 + 32 * half;
        const bf16* xp = X + 4 * q;
        f32x4 S = {0.f, 0.f, 0.f, 0.f};
#pragma unroll
        for (int j = 1; j <= 16; ++j) { const int row = ra - j; if (j <= w && row >= bstart) S += ld4bf(xp + (size_t)row * DM) * rsl[row - r0 + 16]; }
#pragma unroll 8
        for (int i = 0; i < 32; ++i) { const int row = ra + i, t = row - bstart;
            const f32x4 xn = ld4bf(xp + (size_t)row * DM) * rsl[row - r0 + 16];
            f32x4 old = {0.f, 0.f, 0.f, 0.f};
            if (t >= w) old = ld4bf(xp + (size_t)(row - w) * DM) * rsl[row - w - r0 + 16];
            S = S + xn - old;
            const int cnt = (t + 1 < w) ? t + 1 : w;
            const f32x4 p = (S * (1.0f / (float)cnt) - xn) * gn;
            v2u o; o.x = pk2(p[0], p[1]); o.y = pk2(p[2], p[3]); *(v2u*)(PB + (size_t)row * DM + 4 * q) = o; }
    }
}
__device__ __forceinline__ void conv_prep(const bf16* Z, const bf16* GB, const float* cw, bf16* A2, int vcu, int G, int tid) {
    const int gt = vcu * 512 + tid, NT = G * 512;
    for (int it = gt; it < (M / 16) * 128; it += NT) { const int c8 = (it & 127) * 8, rb = (it >> 7) * 16, t0 = rb & (SEQ - 1);
        f32x4 w0[2], w1[2], w2[2];
#pragma unroll
        for (int k = 0; k < 2; ++k) { w0[k] = *(const f32x4*)(cw + c8 + 4 * k); w1[k] = *(const f32x4*)(cw + 1024 + c8 + 4 * k); w2[k] = *(const f32x4*)(cw + 2048 + c8 + 4 * k); }
        const v4u zero = {0u, 0u, 0u, 0u};
        v4u z0 = (t0 >= 2) ? *(const v4u*)(Z + (size_t)(rb - 2) * DM + c8) : zero;
        v4u z1 = (t0 >= 1) ? *(const v4u*)(Z + (size_t)(rb - 1) * DM + c8) : zero;
        v4u zz[16], gg[16];
#pragma unroll
        for (int i = 0; i < 16; ++i) { zz[i] = *(const v4u*)(Z + (size_t)(rb + i) * DM + c8); gg[i] = *(const v4u*)(GB + (size_t)(rb + i) * DM + c8); }
#pragma unroll
        for (int i = 0; i < 16; ++i) { const v4u z2 = zz[i], gb = gg[i]; v4u o;
#pragma unroll
            for (int k = 0; k < 4; ++k) { const int e = 2 * k;
                const float a = bf_lo(gb[k]) * (w0[e >> 2][e & 3] * bf_lo(z0[k]) + w1[e >> 2][e & 3] * bf_lo(z1[k]) + w2[e >> 2][e & 3] * bf_lo(z2[k]));
                const float b = bf_hi(gb[k]) * (w0[(e + 1) >> 2][(e + 1) & 3] * bf_hi(z0[k]) + w1[(e + 1) >> 2][(e + 1) & 3] * bf_hi(z1[k]) + w2[(e + 1) >> 2][(e + 1) & 3] * bf_hi(z2[k]));
                o[k] = pk2(a, b); }
            *(v4u*)(A2 + (size_t)(rb + i) * DM + c8) = o; z0 = z1; z1 = z2; }
    }
}
__device__ __forceinline__ void final_norm(const bf16* X, const float* g, float* out, int vcu, int G, int wave, int lane) {
    const int gw = vcu * NWAVES + wave, NGW = G * NWAVES;
    f32x4 gv[4];
#pragma unroll
    for (int j = 0; j < 4; ++j) gv[j] = ((const f32x4*)g)[lane + 64 * j];
    for (int m0 = gw; m0 < M; m0 += 2 * NGW) {
        f32x4 v[2][4]; float rs[2];
#pragma unroll
        for (int u = 0; u < 2; ++u) { const int m = m0 + u * NGW; const bf16* xr = X + (size_t)(m < M ? m : m0) * DM + 4 * lane;
#pragma unroll
            for (int j = 0; j < 4; ++j) v[u][j] = ld4bf(xr + 256 * j); }
#pragma unroll
        for (int u = 0; u < 2; ++u) { float s = 0.f;
#pragma unroll
            for (int j = 0; j < 4; ++j) s += (v[u][j][0] * v[u][j][0] + v[u][j][1] * v[u][j][1]) + (v[u][j][2] * v[u][j][2] + v[u][j][3] * v[u][j][3]);
            s = wave_sum(s); rs[u] = 1.0f / sqrtf(s * (1.0f / 1024.0f) + 1e-6f); }
#pragma unroll
        for (int u = 0; u < 2; ++u) { const int m = m0 + u * NGW; if (m < M) { f32x4* o = (f32x4*)(out + (size_t)m * DM) + lane;
#pragma unroll
            for (int j = 0; j < 4; ++j) o[64 * j] = v[u][j] * rs[u] * gv[j]; } }
    }
}

__global__ void __launch_bounds__(NWAVES * 64, 2) trunk_fwd(Args args) {
    extern __shared__ __attribute__((aligned(16))) unsigned char lds_raw[];
    LAS unsigned char* lds = (LAS unsigned char*)lds_raw;
    const int Gk = gridDim.x, bx = blockIdx.x;
    const int vcu = (Gk % 8 == 0) ? (bx % 8) * (Gk / 8) + bx / 8 : bx;
    unsigned char* ws = args.ws;
    float* X = args.out;
    bf16* XB = (bf16*)(ws + WS_XB);
    float* SS = (float*)(ws + WS_SS);
    const float* ROPE = (const float*)(ws + WS_ROPE);
    bf16* ACT0 = (bf16*)(ws + WS_ACT);
    bf16* ACT1 = ACT0 + (size_t)M * DM;
    bf16* ACT2 = ACT1 + (size_t)M * DM;
    bf16* ACT3 = ACT2 + (size_t)M * DM;
#define SSBUF(k) (SS + (size_t)((k) & 1) * M * 16)
    volatile LAS unsigned* MISC = (volatile LAS unsigned*)(lds + 147200);
    if (threadIdx.x < 32) MISC[threadIdx.x] = 0u;
    __syncthreads();
    XcdBarrier bar; bar.bar = (unsigned*)ws; bar.x = 0; bar.st = MISC + 8;
    if (args.ph_hi - args.ph_lo > 1) bar = xcd_barrier_post((unsigned*)ws, MISC + 8);

    int probe_state = 0;
    for (int ph = args.ph_lo; ph < args.ph_hi; ++ph) {
        if (ph == 8) continue;
        const int tid = opaque_tid(), lane = tid & 63, wave = __builtin_amdgcn_readfirstlane(tid >> 6);
        int Gp = Gk; asm volatile("" : "+s"(Gp));
        const int G = Gp;
        if (ph == 0) {
            if (PM & 1) prologue(args, lds, vcu, G, wave, lane, tid);
        } else if (ph == N_PHASES - 1) {
            final_norm(XB, args.in[13], X, vcu, G, wave, lane);
        } else {
            const int l = (ph - 1) / 5, s = (ph - 1) % 5, kind = l % 3;
            const int li = (l == 3) ? 1 : 0;
            if (s == 3) {
                pg8::Gemm g{XB, (const bf16*)(ws + WS_WUP) + (size_t)l * FF * DM, M, FF, DM, DM, DM, 0, 0};
                pg8::StaticOrder S; S.init(M, FF, G, bx);
                pg8::EpiUp E{ACT0, SSBUF(2 * l + 1), (LAS float*)(lds + 135168)};
                if (PM & 2) pg8::gemm_phase<pg8::EpiUp>(lds, g, S, E);
            } else if (s == 4 || s == 2 || (s == 1 && kind == 1)) {
                pg8::Gemm g; pg8::EpiRes E; bool run = true;
                E.Xin32 = nullptr; E.xb = XB; E.cscale = nullptr;
                if (s == 4) { g = pg8::Gemm{ACT0, (const bf16*)(ws + WS_WDN) + (size_t)l * DM * FF, M, DM, FF, FF, FF, 0, 1}; E.ssout = SSBUF(2 * l + 2); }
                else {
                    E.ssout = SSBUF(2 * l + 1);
                    if (kind == 0) g = pg8::Gemm{ACT3, (const bf16*)(ws + WS_WO) + (size_t)li * DM * DM, M, DM, DM, DM, DM, 0, 0};
                    else if (kind == 1) { if (s == 1) { g = pg8::Gemm{ACT0, (const bf16*)(ws + WS_WPOOL), M, DM, 256, DM, 256, 256, 0}; E.cscale = args.in[7]; } else run = false; }
                    else g = pg8::Gemm{ACT2, (const bf16*)(ws + WS_WCO), M, DM, DM, DM, DM, 0, 0};
                }
                if (PROBE_REPEAT >= 0 && probe_state == 1) { E.xb = (bf16*)args.out; E.ssout = args.out + 8 * 1024 * 1024; E.Xin32 = nullptr; }
                if (run) { pg8::StaticOrder S; S.init(M, DM, G, bx); if (PM & 4) pg8::gemm_phase<pg8::EpiRes>(lds, g, S, E); }
            } else if (s == 0) {
                if (kind == 0) {
                    pg8::Gemm g{XB, (const bf16*)(ws + WS_WQKV) + (size_t)li * 3072 * DM, M, 3072, DM, DM, DM, 0, 0};
                    pg8::StaticOrder S; S.init(M, 3072, G, bx);
                    pg8::EpiQKV E{ACT0, (size_t)M * DM, SSBUF(2 * l), ROPE, (PROBE_REPEAT >= 0 && probe_state == 1) ? args.out : (float*)(ws + WS_KM) + (size_t)li * 65536, (LAS float*)(lds + 135168)};
                    if (PM & 8) pg8::gemm_phase<pg8::EpiQKV>(lds, g, S, E);
                } else if (kind == 1) {
                    if (PM & 64) pool_prep(XB, SSBUF(2 * l), args.in[2] + l * 1024, ACT0, lds, vcu, G, tid);
                } else {
                    pg8::Gemm g{XB, (const bf16*)(ws + WS_WCI), M, 3072, DM, DM, DM, 0, 0};
                    pg8::StaticOrder S; S.init(M, 3072, G, bx);
                    pg8::EpiConvIn E{ACT0, ACT1, SSBUF(2 * l), (LAS float*)(lds + 135168)};
                    if (PM & 16) pg8::gemm_phase<pg8::EpiConvIn>(lds, g, S, E);
                }
            } else {
                if (kind == 0) { if (PM & 32) att::moba_phase((char*)lds_raw, ACT0, ACT1, ACT2, ACT3, (const float*)(ws + WS_KM) + (size_t)li * 65536, vcu, G); }
                else if (PM & 64) conv_prep(ACT0, ACT1, args.in[9], ACT2, vcu, G, tid);
            }
        }
        if (ph + 1 < args.ph_hi) xcd_barrier(bar);
        if (PROBE_REPEAT >= 0) { if (ph == PROBE_REPEAT && probe_state == 0) { probe_state = 1; --ph; } else if (probe_state == 1) probe_state = 2; }
    }
#undef SSBUF
}

extern "C" void kernel_launch(void* const* d_in, const int* in_sizes, int n_in, void* d_out, int out_size, void* d_ws, size_t ws_size, hipStream_t stream) {
    static int grid = 0;
    if (grid == 0) {
        if (n_in != 14 || in_sizes[0] != M * DM || out_size != M * DM || ws_size < WS_END) { fprintf(stderr, "kernel_launch: unexpected shapes (n_in %d, in0 %d, out %d, ws %zu)\n", n_in, n_in > 0 ? in_sizes[0] : -1, out_size, ws_size); grid = -1; return; }
        int dev = 0, cus = 0, per_cu = 0;
        (void)hipGetDevice(&dev);
        if (hipDeviceGetAttribute(&cus, hipDeviceAttributeMultiprocessorCount, dev) != hipSuccess || cus <= 0) cus = 256;
        if (hipFuncSetAttribute((const void*)trunk_fwd, hipFuncAttributeMaxDynamicSharedMemorySize, LDS_BYTES) != hipSuccess) { fprintf(stderr, "kernel_launch: hipFuncSetAttribute failed\n"); grid = -1; return; }
        if (hipOccupancyMaxActiveBlocksPerMultiprocessor(&per_cu, (const void*)trunk_fwd, NWAVES * 64, LDS_BYTES) != hipSuccess || per_cu < 1) { fprintf(stderr, "kernel_launch: occupancy query says %d blocks per CU\n", per_cu); per_cu = 1; }
        (void)hipGetLastError();
        grid = cus;
        if (grid > 256) grid = 256;
    }
    if (grid < 0) return;
    Args a{};
    for (int i = 0; i < 14; ++i) a.in[i] = (const float*)d_in[i];
    a.out = (float*)d_out; a.ws = (unsigned char*)d_ws;
#if MK_ONE_LAUNCH
    (void)hipMemsetAsync(d_ws, 0, 16384, stream);
    a.ph_lo = 0; a.ph_hi = N_PHASES;
    void* kargs[] = {&a};
    hipError_t e = hipLaunchCooperativeKernel((const void*)trunk_fwd, dim3(grid), dim3(NWAVES * 64), kargs, LDS_BYTES, stream);
    if (e != hipSuccess) fprintf(stderr, "kernel_launch: cooperative launch failed: %s (grid %d)\n", hipGetErrorString(e), grid);
#else
    for (int ph = 0; ph < N_PHASES; ++ph) {
        if (ph == 8) continue;
        a.ph_lo = ph; a.ph_hi = ph + 1;
        hipLaunchKernelGGL(trunk_fwd, dim3(grid), dim3(NWAVES * 64), LDS_BYTES, stream, a);
    }
#endif
}
```
